# Optimizing an MI355X kernel written in HIP

```python
import math
import jax, jax.numpy as jnp
from jax import lax
import numpy as np

D_MODEL = 1024
BATCH = 16
SEQ = 2048
DEPTH = 2

N_META = 16
NORM_EPS = 1e-6
N_MIXERS = 2
N_MLA = (DEPTH + 1) // 2
N_LRU = DEPTH // 2

MLA_HEADS = 8
QK_NOPE = 128
QK_ROPE = 64
V_HEAD = 128
Q_LORA = 384
KV_LORA = 256
ROPE_THETA = 10000.0
Q_BLOCK = 128

LRU_WIDTH = D_MODEL
LRU_BLOCKS = 8
LRU_BW = LRU_WIDTH // LRU_BLOCKS
CONV_W = 4
LRU_C = 8.0

PEER_HEADS = 8
N_KEYS = 128
N_EXPERTS = N_KEYS * N_KEYS
PEER_TOPK = 16
PEER_QDIM = 256
PEER_QHALF = PEER_QDIM // 2
PEER_BLOCK = 256

kernel_name = "hybrid_mla_rglru_peer_meta"


def rms_norm(x, g):
    x32 = x.astype(jnp.float32)
    y = x32 * lax.rsqrt(jnp.mean(x32 * x32, axis=-1, keepdims=True) + NORM_EPS)
    return (y * g.astype(jnp.float32)).astype(x.dtype)


def rope(x, pos):
    half = QK_ROPE // 2
    freqs = ROPE_THETA ** (-jnp.arange(half, dtype=jnp.float32) / half)
    ang = pos.astype(jnp.float32)[..., None] * freqs
    cos = jnp.cos(ang)[:, :, None, :]
    sin = jnp.sin(ang)[:, :, None, :]
    x32 = x.astype(jnp.float32)
    x1, x2 = x32[..., :half], x32[..., half:]
    return jnp.concatenate([x1 * cos - x2 * sin, x2 * cos + x1 * sin], axis=-1).astype(x.dtype)


def mla_mixer(h, pos, w_in, q_norm, w_q_up, kv_norm, w_kv_up, w_out):
    B, L, _ = h.shape
    a = h @ w_in
    q_lat = a[..., :Q_LORA]
    kv_lat = a[..., Q_LORA:Q_LORA + KV_LORA]
    k_rot = a[..., Q_LORA + KV_LORA:]
    q = (rms_norm(q_lat, q_norm) @ w_q_up).reshape(B, L, MLA_HEADS, QK_NOPE + QK_ROPE)
    kv = (rms_norm(kv_lat, kv_norm) @ w_kv_up).reshape(B, L, MLA_HEADS, QK_NOPE + V_HEAD)
    q = jnp.concatenate([q[..., :QK_NOPE], rope(q[..., QK_NOPE:], pos)], axis=-1)
    k_pe = rope(k_rot[:, :, None, :], pos)
    k = jnp.concatenate([kv[..., :QK_NOPE],
                         jnp.broadcast_to(k_pe, (B, L, MLA_HEADS, QK_ROPE))], axis=-1)
    v = kv[..., QK_NOPE:]
    n_qb = -(-L // Q_BLOCK)
    Lp = n_qb * Q_BLOCK
    pad = ((0, 0), (0, Lp - L), (0, 0), (0, 0))
    q, k, v = jnp.pad(q, pad), jnp.pad(k, pad), jnp.pad(v, pad)
    k32 = k.astype(jnp.float32)
    scale = 1.0 / math.sqrt(QK_NOPE + QK_ROPE)
    key_idx = jnp.arange(Lp)
    q_blocks = q.reshape(B, n_qb, Q_BLOCK, MLA_HEADS, QK_NOPE + QK_ROPE).transpose(1, 0, 2, 3, 4)

    def attend(args):
        qi, qb = args
        s = jnp.einsum('bqhd,bkhd->bhqk', qb.astype(jnp.float32), k32) * scale
        q_idx = qi * Q_BLOCK + jnp.arange(Q_BLOCK)
        causal = key_idx[None, :] <= q_idx[:, None]
        s = jnp.where(causal[None, None], s, -1e30)
        p = jax.nn.softmax(s, axis=-1)
        return jnp.einsum('bhqk,bkhd->bqhd', p.astype(v.dtype), v)

    o = lax.map(attend, (jnp.arange(n_qb), q_blocks))
    o = o.transpose(1, 0, 2, 3, 4).reshape(B, Lp, MLA_HEADS * V_HEAD)[:, :L]
    return o @ w_out


def rglru_mixer(h, w_in, conv_w, conv_b, w_gate_a, b_gate_a, w_gate_x, b_gate_x, lam, w_out):
    B, L, _ = h.shape
    proj = h @ w_in
    gate = jax.nn.gelu(proj[..., :LRU_WIDTH], approximate=True)
    xr = proj[..., LRU_WIDTH:]
    xpad = jnp.pad(xr, ((0, 0), (CONV_W - 1, 0), (0, 0)))
    xc = conv_b
    for j in range(CONV_W):
        xc = xc + xpad[:, j:j + L] * conv_w[j]
    xb = xc.reshape(B, L, LRU_BLOCKS, LRU_BW)
    r = jax.nn.sigmoid((jnp.einsum('blnd,nde->blne', xb, w_gate_a).reshape(B, L, LRU_WIDTH)
                        + b_gate_a).astype(jnp.float32))
    i = jax.nn.sigmoid((jnp.einsum('blnd,nde->blne', xb, w_gate_x).reshape(B, L, LRU_WIDTH)
                        + b_gate_x).astype(jnp.float32))
    log_a = -LRU_C * r * jax.nn.softplus(-lam.astype(jnp.float32))
    a = jnp.exp(log_a)
    mult = jnp.sqrt(-jnp.expm1(2.0 * log_a))
    b = mult * (i * xc.astype(jnp.float32))

    def combine(e1, e2):
        a1, b1 = e1
        a2, b2 = e2
        return a1 * a2, a2 * b1 + b2

    _, hs = lax.associative_scan(combine, (a, b), axis=1)
    y = hs.astype(h.dtype) * gate
    return y @ w_out


def peer_ffn(h, w_query, sub_keys, u_tab, v_tab):
    B, L, D = h.shape
    tok = h.reshape(B * L, D)
    T = B * L
    n_blk = -(-T // PEER_BLOCK)
    tok = jnp.pad(tok, ((0, n_blk * PEER_BLOCK - T), (0, 0))).reshape(n_blk, PEER_BLOCK, D)

    def retrieve(xb):
        q = (xb @ w_query).reshape(-1, PEER_HEADS, 2, PEER_QHALF)
        s = jnp.einsum('thpd,pkd->thpk', q, sub_keys).astype(jnp.float32)
        sv, si = lax.top_k(s, PEER_TOPK)
        cand = (sv[:, :, 0, :, None] + sv[:, :, 1, None, :]).reshape(-1, PEER_HEADS, PEER_TOPK * PEER_TOPK)
        cidx = (si[:, :, 0, :, None] * N_KEYS + si[:, :, 1, None, :]).reshape(-1, PEER_HEADS, PEER_TOPK * PEER_TOPK)
        top_s, top_p = lax.top_k(cand, PEER_TOPK)
        eidx = jnp.take_along_axis(cidx, top_p, axis=-1)
        g = jax.nn.softmax(top_s, axis=-1)
        u = u_tab[eidx]
        act = jax.nn.gelu(jnp.einsum('thkd,td->thk', u, xb).astype(jnp.float32))
        w = (g * act).astype(xb.dtype)
        return jnp.einsum('thk,thkd->td', w, v_tab[eidx])

    out = lax.map(retrieve, tok)
    return out.reshape(n_blk * PEER_BLOCK, D)[:T].reshape(B, L, D)


def setup_inputs(seed: int = 0) -> dict:
    key = jax.random.key(seed)
    ks = iter(jax.random.split(key, 32))
    f32 = jnp.float32

    def nrm(shape, scale):
        return jax.random.normal(next(ks), shape, f32) * scale

    def gain(shape):
        return 1.0 + 0.05 * jax.random.normal(next(ks), shape, f32)

    x = jax.random.normal(next(ks), (BATCH, SEQ, D_MODEL), f32)
    positions = jnp.broadcast_to(jnp.arange(SEQ, dtype=jnp.int32)[None, :], (BATCH, SEQ))
    meta_tokens = nrm((N_META, D_MODEL), 1.0)
    mixer_norm = gain((DEPTH, D_MODEL))
    ffn_norm = gain((DEPTH, D_MODEL))
    final_norm = gain((D_MODEL,))

    mla_w_in = nrm((N_MLA, D_MODEL, Q_LORA + KV_LORA + QK_ROPE), D_MODEL ** -0.5)
    mla_q_norm = gain((N_MLA, Q_LORA))
    mla_w_q_up = nrm((N_MLA, Q_LORA, MLA_HEADS * (QK_NOPE + QK_ROPE)), Q_LORA ** -0.5)
    mla_kv_norm = gain((N_MLA, KV_LORA))
    mla_w_kv_up = nrm((N_MLA, KV_LORA, MLA_HEADS * (QK_NOPE + V_HEAD)), KV_LORA ** -0.5)
    mla_w_out = nrm((N_MLA, MLA_HEADS * V_HEAD, D_MODEL), (MLA_HEADS * V_HEAD) ** -0.5)

    lru_w_in = nrm((N_LRU, D_MODEL, 2 * LRU_WIDTH), D_MODEL ** -0.5)
    lru_conv_w = nrm((N_LRU, CONV_W, LRU_WIDTH), CONV_W ** -0.5)
    lru_conv_b = nrm((N_LRU, LRU_WIDTH), 0.01)
    lru_w_gate_a = nrm((N_LRU, LRU_BLOCKS, LRU_BW, LRU_BW), LRU_BW ** -0.5)
    lru_b_gate_a = nrm((N_LRU, LRU_WIDTH), 0.01)
    lru_w_gate_x = nrm((N_LRU, LRU_BLOCKS, LRU_BW, LRU_BW), LRU_BW ** -0.5)
    lru_b_gate_x = nrm((N_LRU, LRU_WIDTH), 0.01)
    u = jax.random.uniform(next(ks), (N_LRU, LRU_WIDTH), f32, 0.9, 0.999)
    s = u ** (1.0 / LRU_C)
    lru_lambda = jnp.log(s) - jnp.log1p(-s)
    lru_w_out = nrm((N_LRU, LRU_WIDTH, D_MODEL), LRU_WIDTH ** -0.5)

    peer_w_query = nrm((DEPTH, D_MODEL, PEER_HEADS * PEER_QDIM), D_MODEL ** -0.5)
    peer_sub_keys = nrm((DEPTH, 2, N_KEYS, PEER_QHALF), PEER_QHALF ** -0.5)
    peer_u = nrm((DEPTH, N_EXPERTS, D_MODEL), D_MODEL ** -0.5)
    peer_v = nrm((DEPTH, N_EXPERTS, D_MODEL), PEER_TOPK ** -0.5)

    return {"x": x, "positions": positions, "meta_tokens": meta_tokens,
            "mixer_norm": mixer_norm, "ffn_norm": ffn_norm, "final_norm": final_norm,
            "mla_w_in": mla_w_in, "mla_q_norm": mla_q_norm, "mla_w_q_up": mla_w_q_up,
            "mla_kv_norm": mla_kv_norm, "mla_w_kv_up": mla_w_kv_up, "mla_w_out": mla_w_out,
            "lru_w_in": lru_w_in, "lru_conv_w": lru_conv_w, "lru_conv_b": lru_conv_b,
            "lru_w_gate_a": lru_w_gate_a, "lru_b_gate_a": lru_b_gate_a,
            "lru_w_gate_x": lru_w_gate_x, "lru_b_gate_x": lru_b_gate_x,
            "lru_lambda": lru_lambda, "lru_w_out": lru_w_out,
            "peer_w_query": peer_w_query, "peer_sub_keys": peer_sub_keys,
            "peer_u": peer_u, "peer_v": peer_v}


def reference(x, positions, meta_tokens, mixer_norm, ffn_norm, final_norm,
              mla_w_in, mla_q_norm, mla_w_q_up, mla_kv_norm, mla_w_kv_up, mla_w_out,
              lru_w_in, lru_conv_w, lru_conv_b, lru_w_gate_a, lru_b_gate_a,
              lru_w_gate_x, lru_b_gate_x, lru_lambda, lru_w_out,
              peer_w_query, peer_sub_keys, peer_u, peer_v):
    B = x.shape[0]
    meta = jnp.broadcast_to(meta_tokens[None].astype(x.dtype), (B, N_META, x.shape[-1]))
    h = jnp.concatenate([meta, x], axis=1)
    meta_pos = jnp.broadcast_to(jnp.arange(N_META, dtype=jnp.int32)[None], (B, N_META))
    pos = jnp.concatenate([meta_pos, positions.astype(jnp.int32) + N_META], axis=1)
    for layer in range(DEPTH):
        hn = rms_norm(h, mixer_norm[layer])
        j = layer // N_MIXERS
        if layer % N_MIXERS == 0:
            mix = mla_mixer(hn, pos, mla_w_in[j], mla_q_norm[j], mla_w_q_up[j],
                            mla_kv_norm[j], mla_w_kv_up[j], mla_w_out[j])
        else:
            mix = rglru_mixer(hn, lru_w_in[j], lru_conv_w[j], lru_conv_b[j],
                              lru_w_gate_a[j], lru_b_gate_a[j], lru_w_gate_x[j],
                              lru_b_gate_x[j], lru_lambda[j], lru_w_out[j])
        h = h + mix
        h = h + peer_ffn(rms_norm(h, ffn_norm[layer]), peer_w_query[layer],
                         peer_sub_keys[layer], peer_u[layer], peer_v[layer])
    out = rms_norm(h, final_norm)
    return out[:, N_META:]
```

```cpp
#include <hip/hip_runtime.h>
#include <cstdio>
#include <cstdint>

#define LAS __attribute__((address_space(3)))
typedef unsigned short bf16_t;
typedef short bf16x8 __attribute__((ext_vector_type(8)));
typedef float f32x4 __attribute__((ext_vector_type(4)));
typedef float f32x16 __attribute__((ext_vector_type(16)));
typedef unsigned u32x4 __attribute__((ext_vector_type(4)));
typedef unsigned u32x2 __attribute__((ext_vector_type(2)));
typedef float f32x2 __attribute__((ext_vector_type(2)));
typedef __bf16 bf16x2_t __attribute__((ext_vector_type(2)));
typedef int i32x8 __attribute__((ext_vector_type(8)));
typedef _Float16 h2_t __attribute__((ext_vector_type(2)));
#define FENCE() asm volatile("" ::: "memory")
__device__ __forceinline__ float dot2bf(unsigned w, unsigned x, float acc) { return __builtin_amdgcn_fdot2_f32_bf16(__builtin_bit_cast(bf16x2_t, w), __builtin_bit_cast(bf16x2_t, x), acc, false); }

constexpr int BATCH = 16, SEQ = 2048, NMETA = 16, LTOK = SEQ + NMETA  , T = BATCH * LTOK  , D = 1024;
constexpr int NTHREADS = 512, NWAVES = 8;
constexpr int NCHUNK = 48, CHUNK = 43;
static_assert(NCHUNK * CHUNK == LTOK, "scan chunking");
constexpr float QSCALE = 0.07216878364870322f * 1.4426950408889634f;
constexpr float LOG2E = 1.4426950408889634f;
#ifndef U_FP4
#define U_FP4 1
#endif
#ifndef V_FP4
#define V_FP4 1
#endif
constexpr int U_ROWB = U_FP4 ? 512 : 1024, V_ROWB = V_FP4 ? 512 : 1024;

constexpr size_t U1 = (size_t)T * 1024 * 2;
constexpr size_t WS_CTL = 0;
constexpr size_t CTL_BYTES = 65536;
constexpr size_t WS_WIN0 = WS_CTL + CTL_BYTES;
constexpr size_t WS_WQUP = WS_WIN0 + 768 * 1024 * 2;
constexpr size_t WS_WK = WS_WQUP + 1536 * 384 * 2;
constexpr size_t WS_WV = WS_WK + 1024 * 256 * 2;
constexpr size_t WS_WOUT0 = WS_WV + 1024 * 256 * 2;
constexpr size_t WS_WLIN = WS_WOUT0 + 1024 * 1024 * 2;
constexpr size_t WS_WGATE = WS_WLIN + 2048 * 1024 * 2;
constexpr size_t WS_WLOUT = WS_WGATE + 2048 * 256 * 2;
constexpr size_t WS_WPQ = WS_WLOUT + 1024 * 1024 * 2;
constexpr size_t WS_KEYS = WS_WPQ + 2 * 2048 * 1024 * 2;
constexpr size_t WS_LRUC = WS_KEYS + 2 * 2 * 128 * 128 * 2;
constexpr size_t WS_ROPE = WS_LRUC + 3 * 1024 * 4;
constexpr size_t WS_AGG = WS_ROPE + (size_t)T * 32 * 2 * 4;
constexpr size_t WS_U = WS_AGG + (size_t)BATCH * NCHUNK * 2 * 1024 * 4;
constexpr size_t WS_V = WS_U + 2ull * 16384 * 1024;
constexpr size_t WS_USC = WS_V + 2ull * 16384 * 1024;
constexpr size_t WS_VSC = WS_USC + 2ull * 16384 * 4;
constexpr size_t WS_RS2 = WS_VSC + 2ull * 16384 * 4;
constexpr size_t WS_H = WS_RS2 + (size_t)T * 4 + 128;
constexpr size_t WS_RA = WS_H + 2 * U1;
constexpr size_t WS_RB = WS_RA + U1;
constexpr size_t WS_H2 = WS_RB + 2 * U1;
constexpr size_t WS_END = WS_H2 + U1;
static_assert(WS_END <= 512ull * 1024 * 1024, "workspace map exceeds 512 MiB");
constexpr size_t DO_KN = 0, DO_QN = U1, DO_KVN = DO_QN + (size_t)T * 384 * 2, DO_KPE = DO_KVN + (size_t)T * 256 * 2;
static_assert(DO_KPE + (size_t)T * 64 * 2 <= (size_t)BATCH * SEQ * D * 4, "d_out scratch map");

constexpr int CW_BAR = 0;
constexpr int CW_ATTN = 4096;

__device__ __forceinline__ float bf2f(unsigned short b) { return __uint_as_float(((unsigned)b) << 16); }
__device__ __forceinline__ unsigned cvt_pk_bf16(float lo, float hi) { bf16x2_t v; v.x = (__bf16)lo; v.y = (__bf16)hi; return __builtin_bit_cast(unsigned, v); }
__device__ __forceinline__ float fexp2(float x) { return __builtin_amdgcn_exp2f(x); }
__device__ __forceinline__ float frcp(float x) { return __builtin_amdgcn_rcpf(x); }
__device__ __forceinline__ float sigmoidf_(float z) { return frcp(1.0f + fexp2(-z * LOG2E)); }
__device__ __forceinline__ float gelu_tanh(float x) { const float u = 0.7978845608028654f * (x + 0.044715f * x * x * x); return x * frcp(1.0f + fexp2(-2.0f * LOG2E * u)); }
__device__ __forceinline__ float lo_bf(unsigned w) { return __uint_as_float(w << 16); }
__device__ __forceinline__ float hi_bf(unsigned w) { return __uint_as_float(w & 0xffff0000u); }
__device__ __forceinline__ float wave_sum(float v) {
    v += __uint_as_float((unsigned)__builtin_amdgcn_update_dpp(0, (int)__float_as_uint(v), 0x128, 0xf, 0xf, false));
    v += __uint_as_float((unsigned)__builtin_amdgcn_update_dpp(0, (int)__float_as_uint(v), 0x124, 0xf, 0xf, false));
    v += __uint_as_float((unsigned)__builtin_amdgcn_update_dpp(0, (int)__float_as_uint(v), 0x122, 0xf, 0xf, false));
    v += __uint_as_float((unsigned)__builtin_amdgcn_update_dpp(0, (int)__float_as_uint(v), 0x121, 0xf, 0xf, false));
    { const auto r = __builtin_amdgcn_permlane16_swap(__float_as_uint(v), __float_as_uint(v), false, false); v = __uint_as_float(r[0]) + __uint_as_float(r[1]); }
    { const auto r = __builtin_amdgcn_permlane32_swap(__float_as_uint(v), __float_as_uint(v), false, false); v = __uint_as_float(r[0]) + __uint_as_float(r[1]); }
    return v;
}

#define XB_TMO      128
#define XB_XCNT(j)  (256  + 64 * (j))
#define XB_XSUB(j)  (1280 + 64 * (j))
#define XB_XGEN(j)  (2304 + 64 * (j))
#define XB_TOP      3328
#define XB_TOPGEN   3392
#define XCD_BAR_WORDS 3456
#define XB_SPIN_CAP (1u << 18)
__device__ __forceinline__ unsigned xb_ld(unsigned* p)              { return __hip_atomic_load(p, __ATOMIC_RELAXED, __HIP_MEMORY_SCOPE_AGENT); }
__device__ __forceinline__ unsigned xb_add(unsigned* p, unsigned v) { return __hip_atomic_fetch_add(p, v, __ATOMIC_RELAXED, __HIP_MEMORY_SCOPE_AGENT); }
__device__ __forceinline__ unsigned xb_xcc_id() { return (unsigned)__builtin_amdgcn_s_getreg((3 << 11) | 20) & 0xFu; }
#define XB_SPIN(cond, bar) do { unsigned _sp = 0; while (cond) { __builtin_amdgcn_s_sleep(1); \
    if ((++_sp & 255u) == 0u) { if (xb_ld(&(bar)[XB_TMO])) break; if (_sp > XB_SPIN_CAP) { atomicAdd(&(bar)[XB_TMO], 1u); break; } } } } while (0)
struct XcdBarrier { unsigned* bar; unsigned x; volatile LAS unsigned* st; };
__device__ __forceinline__ XcdBarrier xcd_barrier_post(unsigned* bar, volatile LAS unsigned* st) {
    XcdBarrier b; b.bar = bar; b.x = xb_xcc_id(); b.st = st;
    if (threadIdx.x == 0) (void)xb_add(&bar[XB_XCNT(b.x)], 1u);
    return b;
}
__device__ __forceinline__ void xcd_barrier_complete(unsigned* bar, unsigned x, unsigned& nloc, unsigned& nx) {
    const unsigned G = gridDim.x * gridDim.y * gridDim.z;
    unsigned sum, cnt, mine, sp = 0u;
    for (;;) {
        sum = 0u; cnt = 0u; mine = 0u;
#pragma unroll
        for (unsigned j = 0; j < 16; ++j) { const unsigned c = xb_ld(&bar[XB_XCNT(j)]); sum += c; cnt += (c > 0u) ? 1u : 0u; mine = (j == x) ? c : mine; }
        if (sum == G) break;
        __builtin_amdgcn_s_sleep(1);
        if ((++sp & 255u) == 0u) { if (xb_ld(&bar[XB_TMO])) break; if (sp > XB_SPIN_CAP) { atomicAdd(&bar[XB_TMO], 1u); break; } }
    }
    nloc = mine > 0u ? mine : 1u; nx = cnt > 0u ? cnt : 1u;
}
__device__ __forceinline__ void xcd_barrier(const XcdBarrier& b) {
    asm volatile("s_waitcnt vmcnt(0)" ::: "memory");
    __syncthreads();
    if (threadIdx.x == 0) {
        unsigned* bar = b.bar;
        __builtin_amdgcn_s_waitcnt(0);
        unsigned nloc = b.st[0], nx = b.st[1];
        if (nloc == 0u) { xcd_barrier_complete(bar, b.x, nloc, nx); b.st[0] = nloc; b.st[1] = nx; }
        const unsigned old = xb_add(&bar[XB_XSUB(b.x)], 1u);
        const unsigned gen = old / nloc;
        if (old + 1u == (gen + 1u) * nloc) {
            __builtin_amdgcn_fence(__ATOMIC_RELEASE, "agent");
            asm volatile("s_waitcnt vmcnt(0)" ::: "memory");
            const unsigned og = xb_add(&bar[XB_TOP], 1u);
            const unsigned tg = og / nx;
            if (og + 1u == (tg + 1u) * nx) xb_add(&bar[XB_TOPGEN], 1u);
            else XB_SPIN(xb_ld(&bar[XB_TOPGEN]) == tg, bar);
            __builtin_amdgcn_fence(__ATOMIC_ACQUIRE, "agent");
            xb_add(&bar[XB_XGEN(b.x)], 1u);
            asm volatile("s_waitcnt vmcnt(0)" ::: "memory");
        } else {
            XB_SPIN(xb_ld(&bar[XB_XGEN(b.x)]) == gen, bar);
            __builtin_amdgcn_fence(__ATOMIC_ACQUIRE, "agent");
            asm volatile("s_waitcnt vmcnt(0)" ::: "memory");
        }
    }
    __syncthreads();
}

namespace pg8 {
constexpr int BM = 256, BK = 64, HALF = 128, HTB = HALF * BK * 2, STAGE_BYTES = 8 * HTB, NXCD = 8, WGM = 8;
__host__ __device__ __forceinline__ int lds_byte(int r, int c) { const int st = (r >> 4) * 2 + (c >> 5), rr = r & 15, cc = c & 31, ob = rr * 64 + cc * 2; return st * 1024 + (ob ^ (((ob >> 9) & 1) << 5)); }
__host__ __device__ __forceinline__ void stage_rc(int b, int& R, int& C) { const int st = b / 1024, sb = b % 1024, swz = sb ^ (((sb >> 9) & 1) << 5); R = (st >> 1) * 16 + swz / 64; C = (st & 1) * 32 + (swz % 64) / 2; }
__host__ __device__ __forceinline__ int perm32(int rho) { const int n = rho >> 4, i = rho & 15; return 8 * (i >> 2) + 4 * n + (i & 3); }
struct Unit { int pm, pn; };
struct Gemm { const bf16_t* A; const bf16_t* Bt; int M, N, K, lda, a_sh, a_cols; };
struct StaticOrder {
    int nM, nN, nwg, G, c;
    __device__ void init(int M, int N, int G_, int c_) { nM = M / BM; nN = N / BM; nwg = nM * nN; G = G_; c = c_; }
    __device__ bool next(int i, Unit& u) const {
        const long L = (long)i * G + c; if (L >= nwg) return false;
        int wgid = (int)L; { const int q = nwg / NXCD, r = nwg % NXCD, xcd = wgid % NXCD, off = wgid / NXCD; wgid = (xcd < r ? xcd * (q + 1) : r * (q + 1) + (xcd - r) * q) + off; }
        const int nig = WGM * nN, gid = wgid / nig, fm = gid * WGM, gsz = (nM - fm) < WGM ? (nM - fm) : WGM;
        u.pm = fm + ((wgid % nig) % gsz); u.pn = (wgid % nig) / gsz; return true;
    }
};

template <class Epi, bool ALIGN_EPI = true, bool SP2 = true>
__device__ __forceinline__ void gemm_phase(LAS unsigned char* lds, const Gemm g, const StaticOrder& S, const Epi& E) {
    const int tid = threadIdx.x, wid = __builtin_amdgcn_readfirstlane(tid >> 6), lane = tid & 63, wr = wid >> 2, wc = wid & 3, fr = lane & 15, fq = lane >> 4;
    const int K = g.K, nt = K / BK, lda = g.lda;
    unsigned voffA[2], voffB[2];
#pragma unroll
    for (int i = 0; i < 2; ++i) { int R, C; stage_rc(tid * 16 + i * 8192, R, C); const int Rb = Epi::PERM ? ((R & ~31) + perm32(R & 31)) : R;
        voffA[i] = (unsigned)(R * lda + C) * 2u; voffB[i] = (unsigned)(Rb * K + C) * 2u; }
    const size_t kstep = (size_t)(BK * 2);
    const size_t hstepA = (size_t)HALF * lda * 2, tstepA = 2 * hstepA;
    const size_t hstepB = (size_t)HALF * K * 2, tstepB = 2 * hstepB;
    const unsigned ldsw = (unsigned)wid * 1024u;
    const int aoff = lds_byte(wr * 64 + fr, fq * 8), boff = lds_byte(wc * 32 + fr, fq * 8);
#define PG8_SA(b, h) (((b) * 2 + (h)) * HTB)
#define PG8_SB(b, h) ((4 + (b) * 2 + (h)) * HTB)
#define PG8_STAGE(bufoff, gbase, voff) do { _Pragma("unroll") for (int _i = 0; _i < 2; ++_i) \
        __builtin_amdgcn_global_load_lds((const unsigned*)((const char*)(gbase) + (voff)[_i]), (LAS unsigned*)(lds + (bufoff) + ldsw + _i * 8192), 16, 0, 0); } while (0)
#define PG8_LDA(dst, b, h) do { _Pragma("unroll") for (int m = 0; m < 4; ++m) _Pragma("unroll") for (int k = 0; k < 2; ++k) dst[m][k] = *(const LAS bf16x8*)(lds + PG8_SA(b, h) + aoff + m * 2048 + k * 1024); } while (0)
#define PG8_LDB(dst, b, h) do { _Pragma("unroll") for (int n = 0; n < 2; ++n) _Pragma("unroll") for (int k = 0; k < 2; ++k) dst[n][k] = *(const LAS bf16x8*)(lds + PG8_SB(b, h) + boff + n * 2048 + k * 1024); } while (0)
#define PG8_MMA(ai, bj, At, Bt) do { __builtin_amdgcn_s_setprio(1); _Pragma("unroll") for (int m = 0; m < 4; ++m) _Pragma("unroll") for (int n = 0; n < 2; ++n) _Pragma("unroll") for (int k = 0; k < 2; ++k) \
        acc[ai][bj][m][n] = __builtin_amdgcn_mfma_f32_16x16x32_bf16(Bt[n][k], At[m][k], acc[ai][bj][m][n], 0, 0, 0); __builtin_amdgcn_s_setprio(0); } while (0)
#define PG8_WAIT_V(n) asm volatile("s_waitcnt vmcnt(" #n ")" ::: "memory")
#define PG8_WAIT_L(n) asm volatile("s_waitcnt lgkmcnt(" #n ")" ::: "memory")
#define PG8_BAR __builtin_amdgcn_s_barrier()
#define PG8_SCHED __builtin_amdgcn_sched_barrier(0)
#define PG8_UA(u_) ((const char*)g.A + (size_t)(u_).pm * tstepA + (size_t)(((u_).pn >> g.a_sh) * g.a_cols) * 2)
    Unit cur, nxt; int ui = 0;
    if (!S.next(0, cur)) return;
    f32x4 acc[2][2][4][2];
#pragma unroll
    for (int a = 0; a < 2; ++a)
#pragma unroll
        for (int b = 0; b < 2; ++b)
#pragma unroll
            for (int m = 0; m < 4; ++m)
#pragma unroll
                for (int n = 0; n < 2; ++n) acc[a][b][m][n] = (f32x4){0.f, 0.f, 0.f, 0.f};
    bf16x8 At[4][2], B0[2][2], B1[2][2];
    const char* cA = PG8_UA(cur); const char* cB = (const char*)g.Bt + (size_t)cur.pn * tstepB;
    if constexpr (SP2) {
        PG8_STAGE(PG8_SB(0, 0), cB, voffB); PG8_STAGE(PG8_SB(0, 1), cB + hstepB, voffB); PG8_STAGE(PG8_SA(0, 0), cA, voffA); PG8_STAGE(PG8_SA(0, 1), cA + hstepA, voffA);
        if (wr == 1) PG8_BAR;
        PG8_WAIT_V(2); PG8_BAR;
        PG8_STAGE(PG8_SB(1, 0), cB + kstep, voffB); PG8_STAGE(PG8_SA(1, 0), cA + kstep, voffA); PG8_STAGE(PG8_SB(1, 1), cB + hstepB + kstep, voffB);
        PG8_WAIT_V(6); PG8_BAR;
    } else {
        PG8_STAGE(PG8_SB(0, 0), cB, voffB); PG8_STAGE(PG8_SA(0, 0), cA, voffA); PG8_STAGE(PG8_SB(0, 1), cB + hstepB, voffB); PG8_STAGE(PG8_SA(0, 1), cA + hstepA, voffA);
        if (wr == 1) PG8_BAR;
        PG8_WAIT_V(4); PG8_BAR;
        PG8_STAGE(PG8_SB(1, 0), cB + kstep, voffB); PG8_STAGE(PG8_SA(1, 0), cA + kstep, voffA); PG8_STAGE(PG8_SB(1, 1), cB + hstepB + kstep, voffB);
        PG8_WAIT_V(6); PG8_BAR;
    }
    for (;;) {
        const bool has_next = S.next(ui + 1, nxt);
        const char* nA = has_next ? PG8_UA(nxt) : cA; const char* nB = has_next ? (const char*)g.Bt + (size_t)nxt.pn * tstepB : cB;
        for (int t = 0; t < nt; t += 2) {
            const bool last = (t == nt - 2);
            const char* a1 = cA + (size_t)(t + 1) * kstep;
            const char* a2 = last ? nA : cA + (size_t)(t + 2) * kstep; const char* b2 = last ? nB : cB + (size_t)(t + 2) * kstep;
            const char* a3 = a2 + kstep; const char* b3 = b2 + kstep;
            if constexpr (SP2) {
            PG8_LDB(B0, 0, 0); PG8_LDB(B1, 0, 1); PG8_SCHED; PG8_LDA(At, 0, 0); PG8_STAGE(PG8_SA(1, 1), a1 + hstepA, voffA);
            PG8_WAIT_V(8); PG8_WAIT_L(0); PG8_BAR; PG8_MMA(0, 0, At, B0); PG8_MMA(0, 1, At, B1); PG8_BAR; PG8_SCHED;
            PG8_LDA(At, 0, 1); PG8_STAGE(PG8_SB(0, 0), b2, voffB); PG8_STAGE(PG8_SB(0, 1), b2 + hstepB, voffB); PG8_STAGE(PG8_SA(0, 0), a2, voffA);
            PG8_WAIT_V(8); PG8_WAIT_L(0); PG8_BAR; PG8_MMA(1, 0, At, B0); PG8_MMA(1, 1, At, B1); PG8_BAR; PG8_SCHED;
            PG8_LDB(B0, 1, 0); PG8_LDB(B1, 1, 1); PG8_SCHED; PG8_LDA(At, 1, 0); PG8_STAGE(PG8_SA(0, 1), a2 + hstepA, voffA);
            PG8_WAIT_V(8); PG8_WAIT_L(0); PG8_BAR; PG8_MMA(0, 0, At, B0); PG8_MMA(0, 1, At, B1); PG8_BAR; PG8_SCHED;
            PG8_LDA(At, 1, 1); PG8_STAGE(PG8_SB(1, 0), b3, voffB); PG8_STAGE(PG8_SB(1, 1), b3 + hstepB, voffB); PG8_STAGE(PG8_SA(1, 0), a3, voffA);
            PG8_WAIT_V(8); PG8_WAIT_L(0); PG8_BAR; PG8_MMA(1, 0, At, B0); PG8_MMA(1, 1, At, B1); PG8_BAR; PG8_SCHED;
            } else {
            PG8_LDB(B0, 0, 0); PG8_SCHED; PG8_LDA(At, 0, 0); PG8_STAGE(PG8_SA(1, 1), a1 + hstepA, voffA);
            PG8_WAIT_L(8); PG8_BAR; PG8_WAIT_L(0); PG8_MMA(0, 0, At, B0); PG8_BAR; PG8_SCHED;
            PG8_LDB(B1, 0, 1); PG8_STAGE(PG8_SB(0, 0), b2, voffB);
            PG8_BAR; PG8_WAIT_L(0); PG8_MMA(0, 1, At, B1); PG8_BAR;
            PG8_LDA(At, 0, 1); PG8_STAGE(PG8_SA(0, 0), a2, voffA);
            PG8_BAR; PG8_WAIT_L(0); PG8_MMA(1, 0, At, B0); PG8_BAR; PG8_SCHED;
            PG8_STAGE(PG8_SB(0, 1), b2 + hstepB, voffB);
            PG8_WAIT_V(6); PG8_BAR; PG8_MMA(1, 1, At, B1); PG8_BAR;
            PG8_LDB(B0, 1, 0); PG8_SCHED; PG8_LDA(At, 1, 0); PG8_STAGE(PG8_SA(0, 1), a2 + hstepA, voffA);
            PG8_WAIT_L(8); PG8_BAR; PG8_WAIT_L(0); PG8_MMA(0, 0, At, B0); PG8_BAR; PG8_SCHED;
            PG8_LDB(B1, 1, 1); PG8_STAGE(PG8_SB(1, 0), b3, voffB);
            PG8_BAR; PG8_WAIT_L(0); PG8_MMA(0, 1, At, B1); PG8_BAR;
            PG8_LDA(At, 1, 1); PG8_STAGE(PG8_SA(1, 0), a3, voffA);
            PG8_BAR; PG8_WAIT_L(0); PG8_MMA(1, 0, At, B0); PG8_BAR; PG8_SCHED;
            PG8_STAGE(PG8_SB(1, 1), b3 + hstepB, voffB);
            PG8_WAIT_V(6); PG8_BAR; PG8_MMA(1, 1, At, B1); PG8_BAR;
            }
        }
        if constexpr (ALIGN_EPI) { if (wr == 0) PG8_BAR; }
        E(acc, cur, wr, wc, fr, fq);
        if (!has_next) break;
#pragma unroll
        for (int a = 0; a < 2; ++a)
#pragma unroll
            for (int b = 0; b < 2; ++b)
#pragma unroll
                for (int m = 0; m < 4; ++m)
#pragma unroll
                    for (int n = 0; n < 2; ++n) acc[a][b][m][n] = (f32x4){0.f, 0.f, 0.f, 0.f};
        cur = nxt; cA = nA; cB = nB; ++ui;
        if constexpr (ALIGN_EPI) { if (wr == 1) PG8_BAR; }
    }
    PG8_WAIT_V(0);
    if constexpr (!ALIGN_EPI) { if (wr == 0) PG8_BAR; }
    PG8_BAR;
#undef PG8_UA
#undef PG8_SA
#undef PG8_SB
#undef PG8_STAGE
#undef PG8_LDA
#undef PG8_LDB
#undef PG8_MMA
#undef PG8_WAIT_V
#undef PG8_WAIT_L
#undef PG8_BAR
#undef PG8_SCHED
}

typedef const f32x4 (&AccRef)[2][2][4][2];

struct EpiBf16 {
    static constexpr bool PERM = true;
    bf16_t* O; int ldc;
    __device__ __forceinline__ void operator()(AccRef acc, const Unit& u, int wr, int wc, int fr, int fq) const {
        const int row0 = u.pm * BM + wr * 64 + fr, col0 = u.pn * BM + wc * 32 + 8 * fq;
#pragma unroll
        for (int ai = 0; ai < 2; ++ai)
#pragma unroll
            for (int m = 0; m < 4; ++m) { bf16_t* rowp = O + (size_t)(row0 + ai * HALF + m * 16) * ldc + col0;
#pragma unroll
                for (int bj = 0; bj < 2; ++bj) { const f32x4 v0 = acc[ai][bj][m][0], v1 = acc[ai][bj][m][1];
                    u32x4 w; w.x = cvt_pk_bf16(v0[0], v0[1]); w.y = cvt_pk_bf16(v0[2], v0[3]); w.z = cvt_pk_bf16(v1[0], v1[1]); w.w = cvt_pk_bf16(v1[2], v1[3]);
                    *(u32x4*)(rowp + bj * HALF) = w; } }
    }
};
struct EpiLruIn {
    static constexpr bool PERM = true;
    bf16_t* G; bf16_t* X; const float* rs;
    __device__ __forceinline__ void operator()(AccRef acc, const Unit& u, int wr, int wc, int fr, int fq) const {
        const int row0 = u.pm * BM + wr * 64 + fr; const bool isg = u.pn < 4; const int col0 = (u.pn & 3) * BM + wc * 32 + 8 * fq; bf16_t* base = isg ? G : X;
        float rss[2][4];
#pragma unroll
        for (int ai = 0; ai < 2; ++ai)
#pragma unroll
            for (int m = 0; m < 4; ++m) rss[ai][m] = rs[row0 + ai * HALF + m * 16];
        FENCE();
#pragma unroll
        for (int ai = 0; ai < 2; ++ai)
#pragma unroll
            for (int m = 0; m < 4; ++m) { bf16_t* rowp = base + (size_t)(row0 + ai * HALF + m * 16) * 1024 + col0; const float r_ = rss[ai][m];
#pragma unroll
                for (int bj = 0; bj < 2; ++bj) { f32x4 v0 = acc[ai][bj][m][0] * r_, v1 = acc[ai][bj][m][1] * r_;
                    if (isg) {
#pragma unroll
                        for (int j = 0; j < 4; ++j) { v0[j] = gelu_tanh(v0[j]); v1[j] = gelu_tanh(v1[j]); } }
                    u32x4 w; w.x = cvt_pk_bf16(v0[0], v0[1]); w.y = cvt_pk_bf16(v0[2], v0[3]); w.z = cvt_pk_bf16(v1[0], v1[1]); w.w = cvt_pk_bf16(v1[2], v1[3]);
                    *(u32x4*)(rowp + bj * HALF) = w; } }
    }
};
struct EpiGate {
    static constexpr bool PERM = true;
    bf16_t* LA; bf16_t* IX; const bf16_t* XC; const float* lruc;
    __device__ __forceinline__ void operator()(AccRef acc, const Unit& u, int wr, int wc, int fr, int fq) const {
        const int row0 = u.pm * BM + wr * 64 + fr, ch0 = u.pn * HALF + wc * 32 + 8 * fq;
        u32x2 xws[2][2][4];
#pragma unroll
        for (int n = 0; n < 2; ++n)
#pragma unroll
            for (int ai = 0; ai < 2; ++ai)
#pragma unroll
                for (int m = 0; m < 4; ++m) xws[n][ai][m] = *(const u32x2*)(XC + (size_t)(row0 + ai * HALF + m * 16) * 1024 + ch0 + 4 * n);
        f32x4 bas[2], bxs[2], sps[2];
#pragma unroll
        for (int n = 0; n < 2; ++n) { bas[n] = *(const f32x4*)(lruc + ch0 + 4 * n); bxs[n] = *(const f32x4*)(lruc + 1024 + ch0 + 4 * n); sps[n] = *(const f32x4*)(lruc + 2048 + ch0 + 4 * n); }
        FENCE();
#pragma unroll
        for (int n = 0; n < 2; ++n) {
            const f32x4 ba = bas[n], bx = bxs[n], sp = sps[n];
#pragma unroll
            for (int ai = 0; ai < 2; ++ai)
#pragma unroll
                for (int m = 0; m < 4; ++m) { const size_t ro = (size_t)(row0 + ai * HALF + m * 16) * 1024 + ch0 + 4 * n;
                    const u32x2 xw = xws[n][ai][m];
                    const float xc[4] = {lo_bf(xw.x), hi_bf(xw.x), lo_bf(xw.y), hi_bf(xw.y)};
                    float la[4], ix[4];
#pragma unroll
                    for (int j = 0; j < 4; ++j) { const float r = sigmoidf_(acc[ai][0][m][n][j] + ba[j]), ii = sigmoidf_(acc[ai][1][m][n][j] + bx[j]); la[j] = -sp[j] * r; ix[j] = ii * xc[j]; }
                    u32x2 w; w.x = cvt_pk_bf16(la[0], la[1]); w.y = cvt_pk_bf16(la[2], la[3]); *(u32x2*)(LA + ro) = w;
                    w.x = cvt_pk_bf16(ix[0], ix[1]); w.y = cvt_pk_bf16(ix[2], ix[3]); *(u32x2*)(IX + ro) = w; }
        }
    }
};
struct EpiResX {
    static constexpr bool PERM = true;
    bf16_t* H; const float* x; const float* meta;
    __device__ __forceinline__ void operator()(AccRef acc, const Unit& u, int wr, int wc, int fr, int fq) const {
        const int row0 = u.pm * BM + wr * 64 + fr, col0 = u.pn * BM + wc * 32 + 8 * fq;
#pragma unroll
        for (int ai = 0; ai < 2; ++ai) {
            f32x4 xs[4][2][2];
            FENCE();
#pragma unroll
            for (int m = 0; m < 4; ++m) { const int row = row0 + ai * HALF + m * 16; const int b = row / LTOK, l = row - b * LTOK;
                const float* bp = (l < NMETA ? meta + (size_t)l * 1024 : x + ((size_t)b * SEQ + (l - NMETA)) * 1024) + col0;
#pragma unroll
                for (int bj = 0; bj < 2; ++bj) { xs[m][bj][0] = *(const f32x4*)(bp + bj * HALF); xs[m][bj][1] = *(const f32x4*)(bp + bj * HALF + 4); } }
            FENCE();
#pragma unroll
            for (int m = 0; m < 4; ++m) { const int row = row0 + ai * HALF + m * 16; bf16_t* rowp = H + (size_t)row * 1024 + col0;
#pragma unroll
                for (int bj = 0; bj < 2; ++bj) { const f32x4 v0 = acc[ai][bj][m][0] + xs[m][bj][0], v1 = acc[ai][bj][m][1] + xs[m][bj][1];
                    u32x4 w; w.x = cvt_pk_bf16(v0[0], v0[1]); w.y = cvt_pk_bf16(v0[2], v0[3]); w.z = cvt_pk_bf16(v1[0], v1[1]); w.w = cvt_pk_bf16(v1[2], v1[3]);
                    *(u32x4*)(rowp + bj * HALF) = w; } } }
    }
};
struct EpiResB {
    static constexpr bool PERM = true;
    bf16_t* H; const bf16_t* B; float sc;
    __device__ __forceinline__ void operator()(AccRef acc, const Unit& u, int wr, int wc, int fr, int fq) const {
        const int row0 = u.pm * BM + wr * 64 + fr, col0 = u.pn * BM + wc * 32 + 8 * fq;
        u32x4 hws[2][4][2];
#pragma unroll
        for (int ai = 0; ai < 2; ++ai)
#pragma unroll
            for (int m = 0; m < 4; ++m)
#pragma unroll
                for (int bj = 0; bj < 2; ++bj) hws[ai][m][bj] = *(const u32x4*)(B + (size_t)(row0 + ai * HALF + m * 16) * 1024 + col0 + bj * HALF);
        FENCE();
#pragma unroll
        for (int ai = 0; ai < 2; ++ai)
#pragma unroll
            for (int m = 0; m < 4; ++m) { const size_t ro = (size_t)(row0 + ai * HALF + m * 16) * 1024 + col0;
#pragma unroll
                for (int bj = 0; bj < 2; ++bj) { const u32x4 hw = hws[ai][m][bj];
                    const f32x4 v0 = acc[ai][bj][m][0] * sc + (f32x4){lo_bf(hw.x), hi_bf(hw.x), lo_bf(hw.y), hi_bf(hw.y)}, v1 = acc[ai][bj][m][1] * sc + (f32x4){lo_bf(hw.z), hi_bf(hw.z), lo_bf(hw.w), hi_bf(hw.w)};
                    u32x4 w; w.x = cvt_pk_bf16(v0[0], v0[1]); w.y = cvt_pk_bf16(v0[2], v0[3]); w.z = cvt_pk_bf16(v1[0], v1[1]); w.w = cvt_pk_bf16(v1[2], v1[3]);
                    *(u32x4*)(H + ro + bj * HALF) = w; } }
    }
};
}

struct Args { const float* in[25]; float* out; unsigned char* ws; int ph_lo, ph_hi, dry, pad; };
constexpr int LDS_BYTES = 155648;
constexpr int MISC_OFF = 155648 - 256;
constexpr int NPHASE = 16;

struct Frame {
    LAS unsigned char* lds; int tid, lane, wave, G, bid;
    const float* const* in; float* out; unsigned char* ws; unsigned* ctl; int dry;
};
#define WSP(T_, off) ((T_*)(F.ws + (off)))
#define DOP(T_, off) ((T_*)((unsigned char*)F.out + (off)))

__device__ __forceinline__ const float* h0_row(const Frame& F, int t) { const int b = t / LTOK, l = t - b * LTOK; return l < NMETA ? F.in[2] + (size_t)l * 1024 : F.in[0] + ((size_t)b * SEQ + (l - NMETA)) * 1024; }

template <class FN>
__device__ __forceinline__ void tr_w(bf16_t* dst, int nrows, int K, FN colp, int ld, int gtid, int gsz, float scale = 1.0f, const float* kscale = nullptr, int nvalid = 1 << 30) {
    const int items = nrows * (K / 8);
    float vn[8], ksn[8];
    auto ld8 = [&](int idx) { const int n = idx % nrows, k8 = idx / nrows; const float* p = colp(n);
#pragma unroll
        for (int j = 0; j < 8; ++j) { vn[j] = p[(size_t)(k8 * 8 + j) * ld]; ksn[j] = kscale ? kscale[k8 * 8 + j] : scale; } };
    if (gtid < items) ld8(gtid);
    for (int idx = gtid; idx < items; idx += gsz) { const int n = idx % nrows, k8 = idx / nrows;
        float v[8];
#pragma unroll
        for (int j = 0; j < 8; ++j) v[j] = vn[j];
        float ks[8];
#pragma unroll
        for (int j = 0; j < 8; ++j) ks[j] = ksn[j];
        if (idx + gsz < items) ld8(idx + gsz);
        const float live = n < nvalid ? 1.0f : 0.0f;
#pragma unroll
        for (int j = 0; j < 8; ++j) v[j] = v[j] * ks[j] * live;
        u32x4 w; w.x = cvt_pk_bf16(v[0], v[1]); w.y = cvt_pk_bf16(v[2], v[3]); w.z = cvt_pk_bf16(v[4], v[5]); w.w = cvt_pk_bf16(v[6], v[7]);
        *(u32x4*)(dst + (size_t)n * K + k8 * 8) = w; }
}
__device__ __forceinline__ int rope_src(int j) { return (j & 1) ? 32 + (j >> 1) : (j >> 1); }

__device__ __forceinline__ void norm_row_wave(const float* src, const float* g, bf16_t* dst, int lane) {
    f32x4 v[4]; float ss = 0.f;
#pragma unroll
    for (int j = 0; j < 4; ++j) { v[j] = *(const f32x4*)(src + j * 256 + lane * 4); ss += v[j][0] * v[j][0] + v[j][1] * v[j][1] + v[j][2] * v[j][2] + v[j][3] * v[j][3]; }
    ss = wave_sum(ss);
    const float rs = rsqrtf(ss * (1.0f / 1024.0f) + 1e-6f);
#pragma unroll
    for (int j = 0; j < 4; ++j) { const f32x4 gg = *(const f32x4*)(g + j * 256 + lane * 4);
        u32x2 w; w.x = cvt_pk_bf16(v[j][0] * rs * gg[0], v[j][1] * rs * gg[1]); w.y = cvt_pk_bf16(v[j][2] * rs * gg[2], v[j][3] * rs * gg[3]);
        *(u32x2*)(dst + j * 256 + lane * 4) = w; }
}

constexpr int TMAIN = 32768, TREM = T - TMAIN;
template <int KB, class AC, class FN>
__device__ __forceinline__ void mini_gemm(const Frame& F, const bf16_t* A, int lda, const bf16_t* Bt, int ldb, int K, int mt, int nt, AC acol, FN fn) {
    const int l15 = F.lane & 15, kq = F.lane >> 4;
    for (int task = F.bid * NWAVES + F.wave; task < mt * nt; task += F.G * NWAVES) {
        const int rt = task % mt, ct = task / mt;
        const bf16_t* ap = A + (size_t)(rt * 16 + l15) * lda + acol(ct) + 8 * kq;
        const bf16_t* bp = Bt + (size_t)(ct * 16 + l15) * ldb + 8 * kq;
        f32x4 acc = (f32x4){0.f, 0.f, 0.f, 0.f};
        for (int k0 = 0; k0 < K; k0 += KB) {
            bf16x8 a[KB / 32], b[KB / 32];
#pragma unroll
            for (int s = 0; s < KB / 32; ++s) { a[s] = *(const bf16x8*)(ap + k0 + 32 * s); b[s] = *(const bf16x8*)(bp + k0 + 32 * s); }
#pragma unroll
            for (int s = 0; s < KB / 32; ++s) acc = __builtin_amdgcn_mfma_f32_16x16x32_bf16(a[s], b[s], acc, 0, 0, 0);
        }
        fn(rt, ct, acc);
    }
}
__device__ __forceinline__ unsigned short f2bf(float f) { return (unsigned short)(cvt_pk_bf16(f, 0.f) & 0xffffu); }

constexpr int P1_UNITS = (T / 256) * 3;
__device__ __forceinline__ void conv_tables(const Frame& F, int r_lo, int r_hi, int widx, int wcount) {
    const float* const* in = F.in;
      static_assert(U_FP4 && V_FP4, "fp4 tables");
      unsigned char* uvd = WSP(unsigned char, WS_U); float* us = WSP(float, WS_USC); float* vs = WSP(float, WS_VSC);
      LAS unsigned char* scr = F.lds + F.wave * 8192; const int lane = F.lane;
      f32x4 tu[4], tv[4];
      const int rstep = wcount * NWAVES; int r = r_lo + widx * NWAVES + F.wave;
      if (r < r_hi) { const float* su = in[23] + (size_t)r * 1024; const float* sv = in[24] + (size_t)r * 1024;
#pragma unroll
          for (int j = 0; j < 4; ++j) { tu[j] = __builtin_nontemporal_load((const f32x4*)(su + (j * 64 + lane) * 4)); tv[j] = __builtin_nontemporal_load((const f32x4*)(sv + (j * 64 + lane) * 4)); } }
      for (; r < r_hi; r += rstep) {
#pragma unroll
          for (int j = 0; j < 4; ++j) { *(LAS f32x4*)(scr + (j * 64 + lane) * 16) = tu[j]; *(LAS f32x4*)(scr + 4096 + (j * 64 + lane) * 16) = tv[j]; }
          asm volatile("s_waitcnt lgkmcnt(0)" ::: "memory");
          if (r + rstep < r_hi) { const float* su = in[23] + (size_t)(r + rstep) * 1024; const float* sv = in[24] + (size_t)(r + rstep) * 1024;
#pragma unroll
              for (int j = 0; j < 4; ++j) { tu[j] = __builtin_nontemporal_load((const f32x4*)(su + (j * 64 + lane) * 4)); tv[j] = __builtin_nontemporal_load((const f32x4*)(sv + (j * 64 + lane) * 4)); } }
          f32x4 v[2][4]; float am[2] = {0.f, 0.f};
#pragma unroll
          for (int tb = 0; tb < 2; ++tb)
#pragma unroll
              for (int j = 0; j < 4; ++j) { v[tb][j] = *(const LAS f32x4*)(scr + tb * 4096 + lane * 64 + j * 16); am[tb] = fmaxf(am[tb], fmaxf(fmaxf(fabsf(v[tb][j][0]), fabsf(v[tb][j][1])), fmaxf(fabsf(v[tb][j][2]), fabsf(v[tb][j][3])))); }
          asm volatile("s_waitcnt lgkmcnt(0)" ::: "memory");
          u32x4 w;
#pragma unroll
          for (int tb = 0; tb < 2; ++tb) { float a = am[tb];
#pragma unroll
              for (int o = 32; o >= 1; o >>= 1) a = fmaxf(a, __shfl_xor(a, o));
              const float sc = a > 0.f ? 6.0f / a : 1.0f, inv = a > 0.f ? a / 6.0f : 1.0f;
              unsigned p = 0u, q = 0u;
              p = __builtin_amdgcn_cvt_scalef32_pk_fp4_f32(p, v[tb][0][0] * sc, v[tb][0][1] * sc, 1.0f, 0); p = __builtin_amdgcn_cvt_scalef32_pk_fp4_f32(p, v[tb][0][2] * sc, v[tb][0][3] * sc, 1.0f, 1);
              p = __builtin_amdgcn_cvt_scalef32_pk_fp4_f32(p, v[tb][1][0] * sc, v[tb][1][1] * sc, 1.0f, 2); p = __builtin_amdgcn_cvt_scalef32_pk_fp4_f32(p, v[tb][1][2] * sc, v[tb][1][3] * sc, 1.0f, 3);
              q = __builtin_amdgcn_cvt_scalef32_pk_fp4_f32(q, v[tb][2][0] * sc, v[tb][2][1] * sc, 1.0f, 0); q = __builtin_amdgcn_cvt_scalef32_pk_fp4_f32(q, v[tb][2][2] * sc, v[tb][2][3] * sc, 1.0f, 1);
              q = __builtin_amdgcn_cvt_scalef32_pk_fp4_f32(q, v[tb][3][0] * sc, v[tb][3][1] * sc, 1.0f, 2); q = __builtin_amdgcn_cvt_scalef32_pk_fp4_f32(q, v[tb][3][2] * sc, v[tb][3][3] * sc, 1.0f, 3);
              if (tb == 0) { w.x = p; w.y = q; } else { w.z = p; w.w = q; }
              if (lane == 0) (tb ? vs : us)[r] = inv; }
          *(u32x4*)(uvd + (size_t)r * 1024 + lane * 16) = w; } }

__device__ __forceinline__ void p0_prologue(const Frame& F) {
    const int gtid = F.bid * NTHREADS + F.tid, gsz = F.G * NTHREADS;
    const float* const* in = F.in;
    { const float* w = in[6];
      tr_w(WSP(bf16_t, WS_WIN0), 768, 1024, [=](int n) -> const float* { if (n >= 704) return w; if (n < 640) return w + n; return w + 640 + rope_src(n - 640); }, 704, gtid, gsz, 1.0f, nullptr, 704); }
    { const float* w = in[8];
      tr_w(WSP(bf16_t, WS_WQUP), 1536, 384, [=](int n) -> const float* { const int h = n / 192, d = n % 192; return w + h * 192 + (d < 128 ? d : 128 + rope_src(d - 128)); }, 1536, gtid, gsz, QSCALE); }
    { const float* w = in[10];
      tr_w(WSP(bf16_t, WS_WK), 1024, 256, [=](int n) -> const float* { return w + (n >> 7) * 256 + (n & 127); }, 2048, gtid, gsz);
      tr_w(WSP(bf16_t, WS_WV), 1024, 256, [=](int n) -> const float* { return w + (n >> 7) * 256 + 128 + (n & 127); }, 2048, gtid, gsz); }
    { const float* w = in[11]; tr_w(WSP(bf16_t, WS_WOUT0), 1024, 1024, [=](int n) -> const float* { return w + n; }, 1024, gtid, gsz); }
    { const float* w = in[12]; tr_w(WSP(bf16_t, WS_WLIN), 2048, 1024, [=](int n) -> const float* { return w + n; }, 2048, gtid, gsz, 1.0f, in[3] + 1024); }
    { const float* w = in[20]; tr_w(WSP(bf16_t, WS_WLOUT), 1024, 1024, [=](int n) -> const float* { return w + n; }, 1024, gtid, gsz); }
    {
      const float* wa = in[15]; const float* wx = in[17]; bf16_t* dst = WSP(bf16_t, WS_WGATE);
      const int items = 2048 * 32;
      for (int idx = gtid; idx < items; idx += gsz) { const int n = idx % 2048, k8 = idx / 2048; const int j = n >> 8, e = n & 127; const bool isx = (n & 128) != 0;
          const float* src = (isx ? wx : wa) + (size_t)j * 128 * 128 + e; const int klo = 128 * (j & 1);
          float v[8];
#pragma unroll
          for (int q = 0; q < 8; ++q) { const int k = k8 * 8 + q - klo; v[q] = (k >= 0 && k < 128) ? src[(size_t)k * 128] : 0.f; }
          u32x4 w; w.x = cvt_pk_bf16(v[0], v[1]); w.y = cvt_pk_bf16(v[2], v[3]); w.z = cvt_pk_bf16(v[4], v[5]); w.w = cvt_pk_bf16(v[6], v[7]);
          *(u32x4*)(dst + (size_t)n * 256 + k8 * 8) = w; } }
    for (int l = 0; l < 2; ++l) { const float* w = in[21] + (size_t)l * 1024 * 2048; tr_w(WSP(bf16_t, WS_WPQ) + (size_t)l * 2048 * 1024, 2048, 1024, [=](int n) -> const float* { return w + n; }, 2048, gtid, gsz, 1.0f, in[4] + l * 1024); }
    { const float* s = in[22]; bf16_t* d = WSP(bf16_t, WS_KEYS); for (int i = gtid; i < 2 * 2 * 128 * 128 / 8; i += gsz) { const f32x4 a = *(const f32x4*)(s + (size_t)i * 8), b = *(const f32x4*)(s + (size_t)i * 8 + 4);
        u32x4 w; w.x = cvt_pk_bf16(a[0], a[1]); w.y = cvt_pk_bf16(a[2], a[3]); w.z = cvt_pk_bf16(b[0], b[1]); w.w = cvt_pk_bf16(b[2], b[3]); *(u32x4*)(d + (size_t)i * 8) = w; } }
    { const int n2 = P1_UNITS - F.G; const bool split = n2 > 0 && n2 + 32 < F.G;
      conv_tables(F, 0, split ? 16384 : 2 * 16384, F.bid, F.G); }
    for (int c = gtid; c < 1024; c += gsz) { float* d = WSP(float, WS_LRUC); d[c] = in[16][c]; d[1024 + c] = in[18][c]; const float nl = -in[19][c];
        d[2048 + c] = 8.0f * (nl > 20.f ? nl : log1pf(expf(nl))); }
    { float* d = WSP(float, WS_ROPE); const int* pos = (const int*)in[1];
      for (int idx = gtid; idx < T * 32; idx += gsz) { const int t = idx >> 5, i = idx & 31; const int b = t / LTOK, l = t - b * LTOK;
          const int p = l < NMETA ? l : pos[b * SEQ + (l - NMETA)] + NMETA;
          const float fr = powf(10000.0f, -(float)i / 32.0f); const float ang = (float)p * fr; float sn, cs; sincosf(ang, &sn, &cs);
          d[(size_t)idx * 2] = cs; d[(size_t)idx * 2 + 1] = sn; } }
    { bf16_t* hn = WSP(bf16_t, WS_RA); const int lane = F.lane, tstep = F.G * NWAVES;
      f32x4 gg[4], vn[4];
#pragma unroll
      for (int j = 0; j < 4; ++j) gg[j] = *(const f32x4*)(in[3] + j * 256 + lane * 4);
      int t = F.bid * NWAVES + F.wave;
      if (t < T) { const float* src = h0_row(F, t);
#pragma unroll
          for (int j = 0; j < 4; ++j) vn[j] = *(const f32x4*)(src + j * 256 + lane * 4); }
      for (; t < T; t += tstep) {
          f32x4 v[4]; float ss = 0.f;
#pragma unroll
          for (int j = 0; j < 4; ++j) { v[j] = vn[j]; ss += v[j][0] * v[j][0] + v[j][1] * v[j][1] + v[j][2] * v[j][2] + v[j][3] * v[j][3]; }
          if (t + tstep < T) { const float* src = h0_row(F, t + tstep);
#pragma unroll
              for (int j = 0; j < 4; ++j) vn[j] = *(const f32x4*)(src + j * 256 + lane * 4); }
          ss = wave_sum(ss);
          const float rs = rsqrtf(ss * (1.0f / 1024.0f) + 1e-6f);
          bf16_t* dst = hn + (size_t)t * 1024;
#pragma unroll
          for (int j = 0; j < 4; ++j) { u32x2 w; w.x = cvt_pk_bf16(v[j][0] * rs * gg[j][0], v[j][1] * rs * gg[j][1]); w.y = cvt_pk_bf16(v[j][2] * rs * gg[j][2], v[j][3] * rs * gg[j][3]);
              *(u32x2*)(dst + j * 256 + lane * 4) = w; } } }
}

__device__ __forceinline__ void norm_phase(const Frame& F, const float* g) {
    const float* h = WSP(float, WS_H); bf16_t* hn = WSP(bf16_t, WS_RA);
    for (int t = F.bid * NWAVES + F.wave; t < T; t += F.G * NWAVES) norm_row_wave(h + (size_t)t * 1024, g, hn + (size_t)t * 1024, F.lane);
}

__device__ __forceinline__ void latnorm_phase(const Frame& F) {
    const bf16_t* a = WSP(bf16_t, WS_RB); bf16_t* qn = DOP(bf16_t, DO_QN); bf16_t* kvn = DOP(bf16_t, DO_KVN); bf16_t* kpe = DOP(bf16_t, DO_KPE);
    const float* gq = F.in[7]; const float* gkv = F.in[9]; const float* rope = WSP(float, WS_ROPE);
    const int lane = F.lane;
    float gg[2][8];
#pragma unroll
    for (int j = 0; j < 2; ++j) { const int c = lane + 64 * j;
#pragma unroll
        for (int q = 0; q < 8; ++q) gg[j][q] = c < 48 ? gq[c * 8 + q] : c < 80 ? gkv[(c - 48) * 8 + q] : 0.f; }
    const bool rl = lane + 64 >= 80 && lane + 64 < 88;
    const int i0 = rl ? (lane + 64 - 80) * 4 : 0;
    u32x4 wn[2]; f32x4 rn[2];
    auto ldrow = [&](int t) { const bf16_t* row = a + (size_t)t * 768;
#pragma unroll
        for (int j = 0; j < 2; ++j) { const int c = lane + 64 * j; wn[j] = c < 88 ? *(const u32x4*)(row + c * 8) : (u32x4){0u, 0u, 0u, 0u}; }
        const float* rp = rope + ((size_t)t * 32 + i0) * 2; rn[0] = rl ? *(const f32x4*)rp : (f32x4){0.f, 0.f, 0.f, 0.f}; rn[1] = rl ? *(const f32x4*)(rp + 4) : (f32x4){0.f, 0.f, 0.f, 0.f}; };
    const int tstep = F.G * NWAVES;
    int t = F.bid * NWAVES + F.wave;
    if (t < T) ldrow(t);
    for (; t < T; t += tstep) {
        const u32x4 wc2[2] = {wn[0], wn[1]}; const f32x4 r0 = rn[0], r1 = rn[1];
        if (t + tstep < T) ldrow(t + tstep);
        float v[2][8]; float sq = 0.f, skv = 0.f;
#pragma unroll
        for (int j = 0; j < 2; ++j) { const int c = lane + 64 * j; const u32x4 w = wc2[j];
            v[j][0] = lo_bf(w.x); v[j][1] = hi_bf(w.x); v[j][2] = lo_bf(w.y); v[j][3] = hi_bf(w.y); v[j][4] = lo_bf(w.z); v[j][5] = hi_bf(w.z); v[j][6] = lo_bf(w.w); v[j][7] = hi_bf(w.w);
            float s_ = 0.f;
#pragma unroll
            for (int q = 0; q < 8; ++q) s_ += v[j][q] * v[j][q];
            if (c < 48) sq += s_; else if (c < 80) skv += s_; }
        sq = wave_sum(sq); skv = wave_sum(skv);
        const float rq = rsqrtf(sq * (1.0f / 384.0f) + 1e-6f), rkv = rsqrtf(skv * (1.0f / 256.0f) + 1e-6f);
#pragma unroll
        for (int j = 0; j < 2; ++j) { const int c = lane + 64 * j; float o[8];
            const float rr = c < 48 ? rq : rkv;
#pragma unroll
            for (int q = 0; q < 8; ++q) o[q] = v[j][q] * rr * gg[j][q];
            if (j == 1 && rl) { const float cs[4] = {r0[0], r0[2], r1[0], r1[2]}, sn[4] = {r0[1], r0[3], r1[1], r1[3]};
#pragma unroll
                for (int p = 0; p < 4; ++p) { o[2 * p] = v[j][2 * p] * cs[p] - v[j][2 * p + 1] * sn[p]; o[2 * p + 1] = v[j][2 * p + 1] * cs[p] + v[j][2 * p] * sn[p]; } }
            u32x4 w; w.x = cvt_pk_bf16(o[0], o[1]); w.y = cvt_pk_bf16(o[2], o[3]); w.z = cvt_pk_bf16(o[4], o[5]); w.w = cvt_pk_bf16(o[6], o[7]);
            if (c < 48) *(u32x4*)(qn + (size_t)t * 384 + c * 8) = w;
            else if (c < 80) *(u32x4*)(kvn + (size_t)t * 256 + (c - 48) * 8) = w;
            else if (c < 88) *(u32x4*)(kpe + (size_t)t * 64 + (c - 80) * 8) = w; }
    }
}

#ifndef AT_KG
#define AT_KG 6
#endif
constexpr int AT_KB = 64 * 384, AT_VB = 128 * 128;
constexpr int AT_K0 = 0, AT_V0 = 2 * AT_KB, AT_LDS = 2 * AT_KB + 2 * AT_VB;
static_assert(AT_LDS <= MISC_OFF, "attention LDS");
__device__ __forceinline__ void attn_phase(const Frame& F) {
    const bf16_t* Q = WSP(bf16_t, WS_H); bf16_t* O = WSP(bf16_t, WS_RA); const float* rope = WSP(float, WS_ROPE);
    const __amdgpu_buffer_rsrc_t krs = __builtin_amdgcn_make_buffer_rsrc((void*)F.out, 0, BATCH * SEQ * D * 4, 0x00020000);
    const __amdgpu_buffer_rsrc_t vrs = __builtin_amdgcn_make_buffer_rsrc((void*)(F.ws + WS_RB + U1), 0, (int)U1, 0x00020000);
    LAS unsigned char* lds = F.lds; volatile LAS int* misc = (volatile LAS int*)(F.lds + MISC_OFF);
    const int tid = F.tid, w = F.wave;
    const int qt_order[9] = {7, 6, 5, 4, 3, 2, 1, 0, 8};
    for (;;) {
        __syncthreads();
        if (tid == 0) misc[16] = (int)atomicAdd(F.ctl + CW_ATTN + 64 * F.dry, 1u);
        __syncthreads();
        const int u = misc[16];
        if (u >= 9 * 128) break;
        int qt = 0;
#pragma unroll
        for (int i = 0; i < 9; ++i) if (u / 128 == i) qt = qt_order[i];
        const int bh = u & 127, b = bh >> 3, h = bh & 7;
        int lane = F.lane; asm volatile("" : "+v"(lane));
        const int q = lane & 31, hf = lane >> 5;
        const int rb = qt < 8 ? 16 + 256 * qt : 0, rlim = qt < 8 ? LTOK : 16;
        const int rowq = rb + 32 * w + q, rowc = rowq < rlim ? rowq : rlim - 1;
        const size_t tq = (size_t)b * LTOK + rowc;
        bf16x8 qf[12];
#pragma unroll
        for (int s = 0; s < 12; ++s) qf[s] = *(const bf16x8*)(Q + tq * 1536 + h * 192 + 16 * s + 8 * hf);
#pragma unroll
        for (int s = 8; s < 12; ++s) {
            const float* rp = rope + (tq * 32 + 8 * (s - 8) + 4 * hf) * 2; const f32x4 c0 = *(const f32x4*)rp, c1 = *(const f32x4*)(rp + 4);
            const u32x4 qw = __builtin_bit_cast(u32x4, qf[s]);
            const float x0 = lo_bf(qw.x), y0 = hi_bf(qw.x), x1 = lo_bf(qw.y), y1 = hi_bf(qw.y), x2 = lo_bf(qw.z), y2 = hi_bf(qw.z), x3 = lo_bf(qw.w), y3 = hi_bf(qw.w);
            u32x4 ow; ow.x = cvt_pk_bf16(x0 * c0[0] - y0 * c0[1], y0 * c0[0] + x0 * c0[1]); ow.y = cvt_pk_bf16(x1 * c0[2] - y1 * c0[3], y1 * c0[2] + x1 * c0[3]);
            ow.z = cvt_pk_bf16(x2 * c1[0] - y2 * c1[1], y2 * c1[0] + x2 * c1[1]); ow.w = cvt_pk_bf16(x3 * c1[2] - y3 * c1[3], y3 * c1[2] + x3 * c1[3]);
            qf[s] = __builtin_bit_cast(bf16x8, ow); }
        f32x16 oacc[4];
#pragma unroll
        for (int i = 0; i < 4; ++i)
#pragma unroll
            for (int r = 0; r < 16; ++r) oacc[i][r] = 0.f;
        float mrun = -1e30f, lrun = 0.f;
        const int wave_row_lo = rb + 32 * w;
        const bool wave_valid = wave_row_lo < rlim;
        const int wave_kmax = (wave_row_lo + 31 < rlim ? wave_row_lo + 31 : rlim - 1);
        const int wg_kmax = (rb + 255 < rlim ? rb + 255 : rlim - 1);
        const int nkt = wg_kmax / 64 + 1;
        int kvo[3], kst[3], vvo[2];
#pragma unroll
        for (int i = 0; i < 3; ++i) { const int o = (w * 3 + i) * 1024 + lane * 16, rho = o / 384, cp = (o - rho * 384) >> 4, c = (cp & 24) | ((cp & 7) ^ ((rho >> 1) & 7));
            const int key = (rho & 0x33) | ((rho & 4) << 1) | ((rho & 8) >> 1), row = b * LTOK + key;
            kvo[i] = c < 16 ? (int)DO_KN + row * 2048 + h * 256 + c * 16 : (int)DO_KPE + row * 128 + (c - 16) * 16; kst[i] = c < 16 ? 64 * 2048 : 64 * 128; }
#pragma unroll
        for (int i = 0; i < 2; ++i) { const int o = (w * 2 + i) * 1024 + lane * 16, d = o >> 7, c = (lane & 7) ^ ((d >> 1) & 7);
            vvo[i] = ((h * 128 + d) * T + b * LTOK + c * 8) * 2; }
        auto issue_tile = [&](int kt, int nbuf) {
#pragma unroll
            for (int i = 0; i < 3; ++i) { __builtin_amdgcn_raw_ptr_buffer_load_lds(krs, (LAS void*)(lds + AT_K0 + nbuf * AT_KB + (w * 3 + i) * 1024), 16, kvo[i], 0, 0, 0); kvo[i] += kst[i]; }
#pragma unroll
            for (int i = 0; i < 2; ++i) __builtin_amdgcn_raw_ptr_buffer_load_lds(vrs, (LAS void*)(lds + AT_V0 + nbuf * AT_VB + (w * 2 + i) * 1024), 16, vvo[i], kt * 128, 0, 0);
        };
        int kro[4], vro[4];
        { const int x = (q >> 1) & 7;
#pragma unroll
          for (int j = 0; j < 4; ++j) { kro[j] = q * 384 + (((2 * j + hf) ^ x) << 4); vro[j] = q * 128 + (((2 * j + hf) ^ x) << 4); } }
        issue_tile(0, 0);
        for (int kt = 0; kt < nkt; ++kt) {
            const int buf = kt & 1;
            asm volatile("s_waitcnt vmcnt(0)" ::: "memory");
            __syncthreads();
            if (kt + 1 < nkt) issue_tile(kt + 1, buf ^ 1);
            if (wave_valid && kt * 64 <= wave_kmax) {
                const LAS unsigned char* kb_ = lds + AT_K0 + buf * AT_KB; const LAS unsigned char* vb_ = lds + AT_V0 + buf * AT_VB;
                f32x16 sacc[2];
#pragma unroll
                for (int kb = 0; kb < 2; ++kb)
#pragma unroll
                    for (int r = 0; r < 16; ++r) sacc[kb][r] = 0.f;
                {
                    constexpr int KG = AT_KG, NG = 24 / KG;
                    bf16x8 kf[2][KG];
#define AT_KLD(g_) _Pragma("unroll") for (int i_ = 0; i_ < KG; ++i_) { const int s_ = ((g_) * KG + i_) % 12, kbb_ = ((g_) * KG + i_) / 12; kf[(g_) & 1][i_] = *(const LAS bf16x8*)(kb_ + kro[s_ & 3] + kbb_ * 32 * 384 + (s_ >> 2) * 128); }
                    AT_KLD(0);
#pragma unroll
                    for (int g = 0; g < NG; ++g) {
                        if (g + 1 < NG) { AT_KLD(g + 1); }
                        __builtin_amdgcn_sched_barrier(0);
#pragma unroll
                        for (int i = 0; i < KG; ++i) { const int s_ = (g * KG + i) % 12, kbb_ = (g * KG + i) / 12; sacc[kbb_] = __builtin_amdgcn_mfma_f32_32x32x16_bf16(kf[g & 1][i], qf[s_], sacc[kbb_], 0, 0, 0); }
                        __builtin_amdgcn_sched_barrier(0);
                    }
#undef AT_KLD
                }
                if (kt * 64 + 63 > wave_row_lo) {
                    asm volatile("" ::: "memory");
#pragma unroll
                    for (int kb = 0; kb < 2; ++kb)
#pragma unroll
                        for (int r = 0; r < 16; ++r) { const int key = kt * 64 + kb * 32 + (r & 3) + 4 * ((r >> 2) & 1) + 8 * hf + 16 * (r >> 3); if (key > rowq) sacc[kb][r] = -1e30f; }
                }
                float mx = -1e30f;
#pragma unroll
                for (int kb = 0; kb < 2; ++kb)
#pragma unroll
                    for (int r = 0; r < 16; ++r) mx = fmaxf(mx, sacc[kb][r]);
                mx = fmaxf(mx, __shfl_xor(mx, 32));
                if (__builtin_amdgcn_ballot_w64(mx > mrun + 8.0f) != 0ull) {
                    const float mnew = fmaxf(mrun, mx), alpha = fexp2(mrun - mnew);
                    lrun *= alpha; mrun = mnew;
#pragma unroll
                    for (int i = 0; i < 4; ++i)
#pragma unroll
                        for (int r = 0; r < 16; ++r) oacc[i][r] *= alpha;
                }
                float ls = 0.f;
#pragma unroll
                for (int kb = 0; kb < 2; ++kb)
#pragma unroll
                    for (int r = 0; r < 16; ++r) { const float p = fexp2(sacc[kb][r] - mrun); sacc[kb][r] = p; ls += p; }
                lrun += ls;
                bf16x8 pf[4];
#pragma unroll
                for (int kb = 0; kb < 2; ++kb)
#pragma unroll
                    for (int s2 = 0; s2 < 2; ++s2) { u32x4 pw; pw.x = cvt_pk_bf16(sacc[kb][8 * s2 + 0], sacc[kb][8 * s2 + 1]); pw.y = cvt_pk_bf16(sacc[kb][8 * s2 + 2], sacc[kb][8 * s2 + 3]);
                        pw.z = cvt_pk_bf16(sacc[kb][8 * s2 + 4], sacc[kb][8 * s2 + 5]); pw.w = cvt_pk_bf16(sacc[kb][8 * s2 + 6], sacc[kb][8 * s2 + 7]); pf[2 * kb + s2] = __builtin_bit_cast(bf16x8, pw); }
                {
                    bf16x8 vf[2][4];
#define AT_VLD(b_) _Pragma("unroll") for (int i_ = 0; i_ < 4; ++i_) vf[(b_) & 1][i_] = *(const LAS bf16x8*)(vb_ + vro[i_] + (b_) * 32 * 128)
                    AT_VLD(0);
#pragma unroll
                    for (int blk = 0; blk < 4; ++blk) {
                        if (blk + 1 < 4) { AT_VLD(blk + 1); }
                        __builtin_amdgcn_sched_barrier(0);
#pragma unroll
                        for (int i = 0; i < 4; ++i) oacc[blk] = __builtin_amdgcn_mfma_f32_32x32x16_bf16(vf[blk & 1][i], pf[i], oacc[blk], 0, 0, 0);
                        __builtin_amdgcn_sched_barrier(0);
                    }
#undef AT_VLD
                }
            }
        }
        const float ltot = lrun + __shfl_xor(lrun, 32), inv = 1.0f / ltot;
        if (rowq < rlim) {
            bf16_t* op = O + tq * 1024 + h * 128;
#pragma unroll
            for (int blk = 0; blk < 4; ++blk)
#pragma unroll
                for (int g4 = 0; g4 < 4; ++g4) { u32x2 ow; ow.x = cvt_pk_bf16(oacc[blk][4 * g4 + 0] * inv, oacc[blk][4 * g4 + 1] * inv); ow.y = cvt_pk_bf16(oacc[blk][4 * g4 + 2] * inv, oacc[blk][4 * g4 + 3] * inv);
                    *(u32x2*)(op + blk * 32 + 8 * g4 + 4 * hf) = ow; }
        }
    }
}

__device__ __forceinline__ unsigned f2key(float f) { const unsigned b = __float_as_uint(f); return b ^ ((unsigned)((int)b >> 31) | 0x80000000u); }
__device__ __forceinline__ float key2f(unsigned k) { const unsigned b = (k & 0x80000000u) ? (k ^ 0x80000000u) : ~k; return __uint_as_float(b); }
template <int N> __device__ __forceinline__ unsigned dpp_ror(unsigned x) { return (unsigned)__builtin_amdgcn_update_dpp(0, (int)x, 0x120 + N, 0xf, 0xf, false); }
__device__ __forceinline__ unsigned rowmax_u(unsigned x) { unsigned y;
    y = dpp_ror<8>(x); x = x > y ? x : y; y = dpp_ror<4>(x); x = x > y ? x : y; y = dpp_ror<2>(x); x = x > y ? x : y; y = dpp_ror<1>(x); x = x > y ? x : y; return x; }
__device__ __forceinline__ float rowsum_f(float x) {
    x += __uint_as_float(dpp_ror<8>(__float_as_uint(x))); x += __uint_as_float(dpp_ror<4>(__float_as_uint(x))); x += __uint_as_float(dpp_ror<2>(__float_as_uint(x))); x += __uint_as_float(dpp_ror<1>(__float_as_uint(x))); return x; }
#define CEX(a, b) do { const unsigned _mx = (a) > (b) ? (a) : (b), _mn = (a) > (b) ? (b) : (a); (a) = _mx; (b) = _mn; } while (0)

constexpr int PE_LE = 0;
constexpr int PE_LG = 8192;
constexpr int PE_RSTD = 16384;
constexpr int PE_KEYS = 16384 + 64;
constexpr int PE_KP = 272;
constexpr int PE_XS = PE_KEYS + 256 * PE_KP;
constexpr int PE_RSA = PE_XS + 8 * 1024;
constexpr int PE_COOP = (PE_RSA + 144 * 4 + 15) / 16 * 16;
constexpr int PE_SLE = PE_COOP + 8 * 4096, PE_SLG = PE_SLE + 1024;
static_assert(PE_XS % 16 == 0 && PE_SLG + 1024 <= MISC_OFF, "peer LDS");

template <bool F4> __device__ __forceinline__ void dec16(const u32x4 a, f32x2 (&c)[8]) {
    if (F4) {
        c[0] = __builtin_amdgcn_cvt_scalef32_pk_f32_fp4(a.x, 1.0f, 0); c[1] = __builtin_amdgcn_cvt_scalef32_pk_f32_fp4(a.x, 1.0f, 1); c[2] = __builtin_amdgcn_cvt_scalef32_pk_f32_fp4(a.x, 1.0f, 2); c[3] = __builtin_amdgcn_cvt_scalef32_pk_f32_fp4(a.x, 1.0f, 3);
        c[4] = __builtin_amdgcn_cvt_scalef32_pk_f32_fp4(a.y, 1.0f, 0); c[5] = __builtin_amdgcn_cvt_scalef32_pk_f32_fp4(a.y, 1.0f, 1); c[6] = __builtin_amdgcn_cvt_scalef32_pk_f32_fp4(a.y, 1.0f, 2); c[7] = __builtin_amdgcn_cvt_scalef32_pk_f32_fp4(a.y, 1.0f, 3);
    } else {
        c[0] = __builtin_amdgcn_cvt_pk_f32_fp8((int)a.x, false); c[1] = __builtin_amdgcn_cvt_pk_f32_fp8((int)a.x, true); c[2] = __builtin_amdgcn_cvt_pk_f32_fp8((int)a.y, false); c[3] = __builtin_amdgcn_cvt_pk_f32_fp8((int)a.y, true);
        c[4] = __builtin_amdgcn_cvt_pk_f32_fp8((int)a.z, false); c[5] = __builtin_amdgcn_cvt_pk_f32_fp8((int)a.z, true); c[6] = __builtin_amdgcn_cvt_pk_f32_fp8((int)a.w, false); c[7] = __builtin_amdgcn_cvt_pk_f32_fp8((int)a.w, true);
    }
}
template <bool F4> __device__ __forceinline__ u32x4 ldrow(__amdgpu_buffer_rsrc_t rs, int e, int lane) {
    if (F4) { const u32x2 w = __builtin_bit_cast(u32x2, __builtin_amdgcn_raw_buffer_load_b64(rs, lane * 8, e * 512, 0)); return (u32x4){w.x, w.y, 0u, 0u}; }
    return __builtin_bit_cast(u32x4, __builtin_amdgcn_raw_buffer_load_b128(rs, lane * 16, e * 1024, 0));
}

template <bool FINAL>
__device__ __forceinline__ void peer_phase(const Frame& F, int layer) {
    const bf16_t* pq = WSP(bf16_t, WS_RB); const bf16_t* hres = WSP(bf16_t, WS_H); bf16_t* hout = WSP(bf16_t, WS_H2); float* rs2 = WSP(float, WS_RS2);
    const float* gffn = F.in[4] + layer * 1024;
    const bf16_t* keys = WSP(bf16_t, WS_KEYS) + (size_t)layer * 2 * 128 * 128;
    const unsigned char* uvtab = WSP(unsigned char, WS_U) + (size_t)layer * 16384 * 1024;
    const float* usc = WSP(float, WS_USC) + layer * 16384; const float* vsc = WSP(float, WS_VSC) + layer * 16384;
    const __amdgpu_buffer_rsrc_t uvrsrc = __builtin_amdgcn_make_buffer_rsrc((void*)uvtab, 0, 16384 * 1024, 0x00020000);
    static_assert(U_FP4 && V_FP4, "the interleaved [u | v] row layout below is for fp4 tables");
    const float* gnext = F.in[5];
    LAS unsigned char* lds = F.lds;
    const int tid = F.tid, lane = F.lane, hh = F.wave;
    unsigned cellpk = 0u, cellvalid = 0u;
    { int c = 0; for (int i = 0; i < 16; ++i) for (int j = 0; j < 16 / (i + 1); ++j) { if ((c & 15) == (lane & 15)) { cellpk |= (unsigned)((i << 4) | j) << (8 * (c >> 4)); cellvalid |= 1u << (c >> 4); } ++c; } }
    for (int c = tid; c < 256 * 16; c += NTHREADS) { const int r = c >> 4, cc = c & 15; *(LAS u32x4*)(lds + PE_KEYS + r * PE_KP + cc * 16) = *(const u32x4*)(keys + (size_t)r * 128 + cc * 8); }
    const int tpw = (T + F.G - 1) / F.G;
    const int tok_lo = F.bid * tpw < T ? F.bid * tpw : T, tok_hi = tok_lo + tpw < T ? tok_lo + tpw : T;
    if (tid == 0) *(LAS int*)(lds + MISC_OFF + 80) = 0;
    for (int tb = tok_lo + hh; tb < tok_hi; tb += 32) {
        u32x4 r0[4], r1[4];
#pragma unroll
        for (int i = 0; i < 4; ++i) { const int t = tb + 8 * i < tok_hi ? tb + 8 * i : tok_hi - 1; const bf16_t* hp = hres + (size_t)t * 1024 + lane * 16; r0[i] = *(const u32x4*)hp; r1[i] = *(const u32x4*)(hp + 8); }
#pragma unroll
        for (int i = 0; i < 4; ++i) { const u32x4 h0 = r0[i], h1 = r1[i];
            float ss = lo_bf(h0.x) * lo_bf(h0.x) + hi_bf(h0.x) * hi_bf(h0.x) + lo_bf(h0.y) * lo_bf(h0.y) + hi_bf(h0.y) * hi_bf(h0.y) + lo_bf(h0.z) * lo_bf(h0.z) + hi_bf(h0.z) * hi_bf(h0.z) + lo_bf(h0.w) * lo_bf(h0.w) + hi_bf(h0.w) * hi_bf(h0.w)
                     + lo_bf(h1.x) * lo_bf(h1.x) + hi_bf(h1.x) * hi_bf(h1.x) + lo_bf(h1.y) * lo_bf(h1.y) + hi_bf(h1.y) * hi_bf(h1.y) + lo_bf(h1.z) * lo_bf(h1.z) + hi_bf(h1.z) * hi_bf(h1.z) + lo_bf(h1.w) * lo_bf(h1.w) + hi_bf(h1.w) * hi_bf(h1.w);
            ss = wave_sum(ss);
            if (lane == 0 && tb + 8 * i < tok_hi) *(LAS float*)(lds + PE_RSA + (tb + 8 * i - tok_lo) * 4) = rsqrtf(ss * (1.0f / 1024.0f) + 1e-6f); } }
    __syncthreads();
    const bool odd = ((tok_hi - tok_lo) & 1) != 0;
    const int npairs = (tok_hi - tok_lo) / 2;
    int it = (odd && hh == 0) ? -1 : 0;
    for (;;) {
        int tok0 = tok_hi - 1;
        if (it == 0) { int pr = 0; if (lane == 0) pr = __atomic_fetch_add((LAS int*)(lds + MISC_OFF + 80), 1, __ATOMIC_RELAXED); pr = __builtin_amdgcn_readfirstlane(pr);
            if (pr < npairs) tok0 = tok_lo + 2 * pr; else it = 1; }
        const bool coop = it == 1;
        if (coop) { if (!odd) break; __syncthreads(); }
        const bool lo_item = it != 0;
        const int ntok = lo_item ? 1 : 2;
        LAS unsigned char* lle = lo_item ? lds + PE_SLE : lds + PE_LE + hh * 1024; LAS unsigned char* llg = lo_item ? lds + PE_SLG : lds + PE_LG + hh * 1024;
        const int hd_lo = coop ? hh : 0, hd_hi = coop ? hh + 1 : 8;
        int lg = lane; asm volatile("" : "+v"(lg));
        const int l15 = lg & 15, kq = lg >> 4, rowbase = lg & 48;
        const LAS unsigned char* kl = lds + PE_KEYS + l15 * PE_KP + kq * 16;
#ifndef PESEL
#define PESEL 3
#endif
        if ((PESEL & 1) && !coop) {
            const int trow = (l15 >> 3) < ntok ? (l15 >> 3) : ntok - 1;
            const bf16_t* qrow = pq + (size_t)(tok0 + trow) * 2048 + (l15 & 7) * 256;
            unsigned topv[2][4];
#pragma unroll
            for (int p = 0; p < 2; ++p) {
                bf16x8 af[4];
#pragma unroll
                for (int s = 0; s < 4; ++s) af[s] = *(const bf16x8*)(qrow + p * 128 + 32 * s + 8 * kq);
                unsigned v[4][8];
#pragma unroll
                for (int nb = 0; nb < 8; ++nb) { f32x4 acc = (f32x4){0.f, 0.f, 0.f, 0.f}; FENCE();
#pragma unroll
                    for (int s = 0; s < 4; ++s) { const bf16x8 bfr = *(const LAS bf16x8*)(kl + (p * 128 + 16 * nb) * PE_KP + 64 * s);
                        acc = __builtin_amdgcn_mfma_f32_16x16x32_bf16(af[s], bfr, acc, 0, 0, 0); }
#pragma unroll
                    for (int r = 0; r < 4; ++r) v[r][nb] = (f2key(acc[r]) & ~127u) | (unsigned)(16 * nb + l15); }
#pragma unroll
                for (int r = 0; r < 4; ++r) {
                    unsigned* a = v[r];
                    CEX(a[0], a[1]); CEX(a[2], a[3]); CEX(a[4], a[5]); CEX(a[6], a[7]);
                    CEX(a[0], a[2]); CEX(a[1], a[3]); CEX(a[4], a[6]); CEX(a[5], a[7]);
                    CEX(a[1], a[2]); CEX(a[5], a[6]);
                    CEX(a[0], a[4]); CEX(a[1], a[5]); CEX(a[2], a[6]); CEX(a[3], a[7]);
                    CEX(a[2], a[4]); CEX(a[3], a[5]);
                    CEX(a[1], a[2]); CEX(a[3], a[4]); CEX(a[5], a[6]);
                    unsigned top = 0u;
#pragma unroll
                    for (int k = 0; k < 16; ++k) { const unsigned mx = rowmax_u(a[0]); top = (l15 == k) ? mx : top; const bool pop = a[0] == mx;
#pragma unroll
                        for (int j = 0; j < 7; ++j) a[j] = pop ? a[j + 1] : a[j];
                        a[7] = pop ? 0u : a[7]; }
                    topv[p][r] = top; }
            }
#pragma unroll
            for (int r = 0; r < 4; ++r) {
                unsigned cnd[4];
#pragma unroll
                for (int sl = 0; sl < 4; ++sl) { const int ij = (cellpk >> (8 * sl)) & 255, i = ij >> 4, j = ij & 15;
                    const unsigned ka = (unsigned)__builtin_amdgcn_ds_bpermute((rowbase + i) * 4, (int)topv[0][r]), kb = (unsigned)__builtin_amdgcn_ds_bpermute((rowbase + j) * 4, (int)topv[1][r]);
                    const float sum = key2f(ka) + key2f(kb);
                    cnd[sl] = ((cellvalid >> sl) & 1u) ? ((f2key(sum) & ~255u) | (unsigned)ij) : 0u; }
                CEX(cnd[0], cnd[1]); CEX(cnd[2], cnd[3]); CEX(cnd[0], cnd[2]); CEX(cnd[1], cnd[3]); CEX(cnd[1], cnd[2]);
                unsigned win = 0u;
#pragma unroll
                for (int k = 0; k < 16; ++k) { const unsigned mx = rowmax_u(cnd[0]); win = (l15 == k) ? mx : win; const bool pop = cnd[0] == mx;
                    cnd[0] = pop ? cnd[1] : cnd[0]; cnd[1] = pop ? cnd[2] : cnd[1]; cnd[2] = pop ? cnd[3] : cnd[2]; cnd[3] = pop ? 0u : cnd[3]; }
                const int wi = (win >> 4) & 15, wj = win & 15;
                const unsigned ka = (unsigned)__builtin_amdgcn_ds_bpermute((rowbase + wi) * 4, (int)topv[0][r]), kb = (unsigned)__builtin_amdgcn_ds_bpermute((rowbase + wj) * 4, (int)topv[1][r]);
                const int eidx = (int)((ka & 127u) * 128u + (kb & 127u));
                const float sv = key2f(win), smax = key2f(rowmax_u(win));
                const int rho = 4 * kq + r;
                const float rst = *(const LAS float*)(lds + PE_RSA + (tok0 - tok_lo + ((rho >> 3) < ntok ? (rho >> 3) : 0)) * 4);
                const float e = fexp2((sv - smax) * (rst * LOG2E)), den = rowsum_f(e), gk = e / den;
                *(LAS int*)(lle + (rho * 16 + l15) * 4) = eidx;
                *(LAS float*)(llg + (rho * 16 + l15) * 4) = gk;
            }
        }
        if ((PESEL & 2) && it >= 0) for (int tl = 0; tl < ntok; ++tl) {
            const int t = tok0 + tl;
            int ln = lane; asm volatile("" : "+v"(ln));
            const u32x4 h0 = *(const u32x4*)(hres + (size_t)t * 1024 + ln * 16), h1 = *(const u32x4*)(hres + (size_t)t * 1024 + ln * 16 + 8);
            const unsigned hp8[8] = {h0.x, h0.y, h0.z, h0.w, h1.x, h1.y, h1.z, h1.w};
            i32x8 xB;
            { LAS unsigned char* xscr = lds + PE_XS + hh * 1024;
              const float rst = *(const LAS float*)(lds + PE_RSA + (tok0 - tok_lo + tl) * 4);
              float xv[16];
#pragma unroll
              for (int q = 0; q < 8; ++q) { const f32x2 gg = *(const f32x2*)(gffn + ln * 16 + 2 * q); xv[2 * q] = lo_bf(hp8[q]) * rst * gg.x; xv[2 * q + 1] = hi_bf(hp8[q]) * rst * gg.y; }
              u32x4 xb;
#pragma unroll
              for (int d4 = 0; d4 < 4; ++d4) { int w_ = 0; w_ = __builtin_amdgcn_cvt_pk_fp8_f32(xv[4 * d4], xv[4 * d4 + 1], w_, false); w_ = __builtin_amdgcn_cvt_pk_fp8_f32(xv[4 * d4 + 2], xv[4 * d4 + 3], w_, true); xb[d4] = (unsigned)w_; }
              *(LAS u32x4*)(xscr + ln * 16) = xb;
              asm volatile("s_waitcnt lgkmcnt(0)" ::: "memory");
              const int n_ = ln & 15, kq_ = ln >> 4;
              const u32x4 b0 = *(const LAS u32x4*)(xscr + (8 * kq_ + n_) * 16), b1 = *(const LAS u32x4*)(xscr + (32 + 8 * kq_ + n_) * 16);
              const bool bz = (kq_ & 1) != 0;
              xB = (i32x8){bz ? 0 : (int)b0.x, bz ? 0 : (int)b0.y, bz ? 0 : (int)b0.z, bz ? 0 : (int)b0.w, bz ? 0 : (int)b1.x, bz ? 0 : (int)b1.y, bz ? 0 : (int)b1.z, bz ? 0 : (int)b1.w}; }
            const bool dvalid = ((ln & 15) >> 2) == (ln >> 4);
            float dm0 = (dvalid && (ln & 3) == 0) ? 1.f : 0.f, dm1 = (dvalid && (ln & 3) == 1) ? 1.f : 0.f, dm2 = (dvalid && (ln & 3) == 2) ? 1.f : 0.f, dm3 = (dvalid && (ln & 3) == 3) ? 1.f : 0.f;
            asm volatile("" : "+v"(dm0), "+v"(dm1), "+v"(dm2), "+v"(dm3));
            h2_t oa[8];
#pragma unroll
            for (int j = 0; j < 8; ++j) oa[j] = (h2_t){(_Float16)0.f, (_Float16)0.f};
            const int ksel = ((ln >> 2) & 3) + 4 * ((ln >> 4) & 1) + 8 * (ln >> 5);
#pragma unroll 1
            for (int hd = hd_lo; hd < hd_hi; ++hd) {
                int es[16];
#pragma unroll
                for (int i4 = 0; i4 < 4; ++i4) { const u32x4 ev = *(const LAS u32x4*)(lle + ((tl * 8 + hd) * 16 + 4 * i4) * 4);
                    es[4 * i4] = __builtin_amdgcn_readfirstlane((int)ev.x); es[4 * i4 + 1] = __builtin_amdgcn_readfirstlane((int)ev.y); es[4 * i4 + 2] = __builtin_amdgcn_readfirstlane((int)ev.z); es[4 * i4 + 3] = __builtin_amdgcn_readfirstlane((int)ev.w); }
                u32x4 ru[16];
#pragma unroll
                for (int k = 0; k < 16; ++k) ru[k] = __builtin_bit_cast(u32x4, __builtin_amdgcn_raw_buffer_load_b128(uvrsrc, ln * 16, es[k] * 1024, 0));
                const int esel = *(const LAS int*)(lle + ((tl * 8 + hd) * 16 + ksel) * 4);
                const float gsel = *(const LAS float*)(llg + ((tl * 8 + hd) * 16 + ksel) * 4);
                const float usel = usc[esel], vsel = vsc[esel];
                __builtin_amdgcn_sched_barrier(0);
                float dt[16];
#pragma unroll
                for (int k = 0; k < 16; ++k) { const f32x4 dd = __builtin_amdgcn_mfma_scale_f32_16x16x128_f8f6f4((i32x8){(int)ru[k].x, (int)ru[k].y, (int)ru[k].z, (int)ru[k].w, 0, 0, 0, 0}, xB, (f32x4){0.f, 0.f, 0.f, 0.f}, 4, 0, 0, 0x7f7f7f7f, 0, 0x7f7f7f7f);
                    dt[k] = dd[0] * dm0 + dd[1] * dm1 + dd[2] * dm2 + dd[3] * dm3; }
                float wsel;
                {
                    float a8[8], b4[4];
#pragma unroll
                    for (int k = 0; k < 8; ++k) { const auto r_ = __builtin_amdgcn_permlane32_swap(__float_as_uint(dt[k]), __float_as_uint(dt[k + 8]), false, false); a8[k] = __uint_as_float(r_[0]) + __uint_as_float(r_[1]); }
#pragma unroll
                    for (int k = 0; k < 4; ++k) { const auto r_ = __builtin_amdgcn_permlane16_swap(__float_as_uint(a8[k]), __float_as_uint(a8[k + 4]), false, false); b4[k] = rowsum_f(__uint_as_float(r_[0]) + __uint_as_float(r_[1])); }
                    const int jj = (ln >> 2) & 3;
                    const float d1 = jj == 0 ? b4[0] : jj == 1 ? b4[1] : jj == 2 ? b4[2] : b4[3];
                    wsel = gsel * gelu_tanh(d1 * usel) * vsel;
                }
                const int wselh = (int)__builtin_bit_cast(unsigned short, (_Float16)wsel);
#pragma unroll
                for (int k = 0; k < 16; ++k) { const int wb = __builtin_amdgcn_readlane(wselh, 16 * (((k >> 2) & 1) + 2 * (k >> 3)) + 4 * (k & 3));
                    const _Float16 wh = __builtin_bit_cast(_Float16, (unsigned short)wb); const h2_t wv = (h2_t){wh, wh};
                    h2_t c[8];
                    c[0] = __builtin_amdgcn_cvt_scalef32_pk_f16_fp4(ru[k].z, 1.0f, 0); c[1] = __builtin_amdgcn_cvt_scalef32_pk_f16_fp4(ru[k].z, 1.0f, 1); c[2] = __builtin_amdgcn_cvt_scalef32_pk_f16_fp4(ru[k].z, 1.0f, 2); c[3] = __builtin_amdgcn_cvt_scalef32_pk_f16_fp4(ru[k].z, 1.0f, 3);
                    c[4] = __builtin_amdgcn_cvt_scalef32_pk_f16_fp4(ru[k].w, 1.0f, 0); c[5] = __builtin_amdgcn_cvt_scalef32_pk_f16_fp4(ru[k].w, 1.0f, 1); c[6] = __builtin_amdgcn_cvt_scalef32_pk_f16_fp4(ru[k].w, 1.0f, 2); c[7] = __builtin_amdgcn_cvt_scalef32_pk_f16_fp4(ru[k].w, 1.0f, 3);
#pragma unroll
                    for (int q = 0; q < 8; ++q) oa[q] = c[q] * wv + oa[q]; }
            }
            float oaf[16];
#pragma unroll
            for (int q = 0; q < 8; ++q) { oaf[2 * q] = (float)oa[q].x; oaf[2 * q + 1] = (float)oa[q].y; }
            bool fin = true;
            if (coop) {
#pragma unroll
                for (int j4 = 0; j4 < 4; ++j4) *(LAS f32x4*)(lds + PE_COOP + hh * 4096 + ln * 64 + j4 * 16) = (f32x4){oaf[4 * j4], oaf[4 * j4 + 1], oaf[4 * j4 + 2], oaf[4 * j4 + 3]};
                __syncthreads();
                fin = hh == 0;
                if (fin) {
#pragma unroll
                    for (int j = 0; j < 16; ++j) oaf[j] = 0.f;
#pragma unroll
                    for (int w8 = 0; w8 < 8; ++w8)
#pragma unroll
                        for (int j4 = 0; j4 < 4; ++j4) { const f32x4 pv4 = *(const LAS f32x4*)(lds + PE_COOP + w8 * 4096 + ln * 64 + j4 * 16); oaf[4 * j4] += pv4[0]; oaf[4 * j4 + 1] += pv4[1]; oaf[4 * j4 + 2] += pv4[2]; oaf[4 * j4 + 3] += pv4[3]; } } }
            if (fin) {
                float acc[16];
#pragma unroll
                for (int q = 0; q < 8; ++q) { acc[2 * q] = lo_bf(hp8[q]) + oaf[2 * q]; acc[2 * q + 1] = hi_bf(hp8[q]) + oaf[2 * q + 1]; }
                float ss = 0.f;
#pragma unroll
                for (int j = 0; j < 16; ++j) ss += acc[j] * acc[j];
                ss = wave_sum(ss);
                const float rs = rsqrtf(ss * (1.0f / 1024.0f) + 1e-6f);
                if (F.dry) {}
                else if (FINAL) { const int b = t / LTOK, l = t - b * LTOK;
                    if (l >= NMETA) { float* op = F.out + ((size_t)b * SEQ + (l - NMETA)) * 1024 + ln * 16;
                        f32x4 ggs[4];
#pragma unroll
                        for (int j4 = 0; j4 < 4; ++j4) ggs[j4] = *(const f32x4*)(gnext + ln * 16 + 4 * j4);
                        FENCE();
#pragma unroll
                        for (int j4 = 0; j4 < 4; ++j4) { const f32x4 gg = ggs[j4];
                            *(f32x4*)(op + 4 * j4) = (f32x4){acc[4 * j4] * rs * gg[0], acc[4 * j4 + 1] * rs * gg[1], acc[4 * j4 + 2] * rs * gg[2], acc[4 * j4 + 3] * rs * gg[3]}; } } }
                else {
                    u32x4 w0, w1; w0.x = cvt_pk_bf16(acc[0], acc[1]); w0.y = cvt_pk_bf16(acc[2], acc[3]); w0.z = cvt_pk_bf16(acc[4], acc[5]); w0.w = cvt_pk_bf16(acc[6], acc[7]);
                    w1.x = cvt_pk_bf16(acc[8], acc[9]); w1.y = cvt_pk_bf16(acc[10], acc[11]); w1.z = cvt_pk_bf16(acc[12], acc[13]); w1.w = cvt_pk_bf16(acc[14], acc[15]);
                    *(u32x4*)(hout + (size_t)t * 1024 + ln * 16) = w0; *(u32x4*)(hout + (size_t)t * 1024 + ln * 16 + 8) = w1;
                    if (ln == 0) rs2[t] = rs; }
            }
        }
        if (coop) break;
        if (it < 0) it = 0;
    }
}

__device__ __forceinline__ void conv_phase(const Frame& F) {
    const bf16_t* xr = WSP(bf16_t, WS_RB + U1); bf16_t* xc = WSP(bf16_t, WS_RA); const float* cw = F.in[13]; const float* cb = F.in[14];
    const int gtid = F.bid * NTHREADS + F.tid, gsz = F.G * NTHREADS;
    u32x4 wn[4];
    auto ld = [&](int idx) { const int t = idx >> 7, c8 = (idx & 127) * 8, l = t % LTOK;
#pragma unroll
        for (int j = 0; j < 4; ++j) { const int dl = 3 - j; wn[j] = (l - dl >= 0) ? *(const u32x4*)(xr + (size_t)(t - dl) * 1024 + c8) : (u32x4){0u, 0u, 0u, 0u}; } };
    const int c8 = (gtid & 127) * 8;
    float cwr[4][8], cbr[8];
#pragma unroll
    for (int q = 0; q < 8; ++q) { cbr[q] = cb[c8 + q];
#pragma unroll
        for (int j = 0; j < 4; ++j) cwr[j][q] = cw[j * 1024 + c8 + q]; }
    if (gtid < T * 128) ld(gtid);
    for (int idx = gtid; idx < T * 128; idx += gsz) { const int t = idx >> 7;
        u32x4 wc4[4];
#pragma unroll
        for (int j = 0; j < 4; ++j) wc4[j] = wn[j];
        if (idx + gsz < T * 128) ld(idx + gsz);
        float acc[8];
#pragma unroll
        for (int q = 0; q < 8; ++q) acc[q] = cbr[q];
#pragma unroll
        for (int j = 0; j < 4; ++j) { const u32x4 w = wc4[j];
            const float xv[8] = {lo_bf(w.x), hi_bf(w.x), lo_bf(w.y), hi_bf(w.y), lo_bf(w.z), hi_bf(w.z), lo_bf(w.w), hi_bf(w.w)};
#pragma unroll
            for (int q = 0; q < 8; ++q) acc[q] += xv[q] * cwr[j][q]; }
        u32x4 o; o.x = cvt_pk_bf16(acc[0], acc[1]); o.y = cvt_pk_bf16(acc[2], acc[3]); o.z = cvt_pk_bf16(acc[4], acc[5]); o.w = cvt_pk_bf16(acc[6], acc[7]);
        *(u32x4*)(xc + (size_t)t * 1024 + c8) = o; }
}
template <int PASS>
__device__ __forceinline__ void scan_phase(const Frame& F) {
    const bf16_t* la = DOP(bf16_t, 0); const bf16_t* ix = WSP(bf16_t, WS_RB + U1); const bf16_t* gate = WSP(bf16_t, WS_RB); bf16_t* y = WSP(bf16_t, WS_RA);
    float* agg = WSP(float, WS_AGG);
    const int gtid = F.bid * NTHREADS + F.tid, gsz = F.G * NTHREADS;
    for (int idx = gtid; idx < BATCH * NCHUNK * 128; idx += gsz) { const int cg = idx & 127, bc = idx >> 7, ch = bc % NCHUNK, b = bc / NCHUNK, c8 = cg * 8;
        float hst[8], ap[8];
#pragma unroll
        for (int q = 0; q < 8; ++q) { hst[q] = 0.f; ap[q] = 1.f; }
        if (PASS == 2) { for (int cc = 0; cc < ch; ++cc) { const float* ag = agg + ((size_t)(b * NCHUNK + cc) * 2) * 1024 + c8;
                const f32x4 a0 = *(const f32x4*)ag, a1 = *(const f32x4*)(ag + 4), e0 = *(const f32x4*)(ag + 1024), e1 = *(const f32x4*)(ag + 1028);
#pragma unroll
                for (int q = 0; q < 4; ++q) { hst[q] = a0[q] * hst[q] + e0[q]; hst[4 + q] = a1[q] * hst[4 + q] + e1[q]; } } }
        const size_t t0 = (size_t)b * LTOK + (size_t)ch * CHUNK;
        u32x4 lwA[4], iwA[4], gwA[4], lwB[4], iwB[4], gwB[4];
#define SCAN_LD(X, NB, s0) do { _Pragma("unroll") for (int j = 0; j < NB; ++j) { const size_t off = (t0 + (s0) + j) * 1024 + c8; lw##X[j] = *(const u32x4*)(la + off); iw##X[j] = *(const u32x4*)(ix + off); if (PASS == 2) gw##X[j] = *(const u32x4*)(gate + off); } } while (0)
#define SCAN_CP(X, NB, s0) do { _Pragma("unroll") for (int j = 0; j < NB; ++j) { const u32x4 lw = lw##X[j], iw = iw##X[j]; \
                const float lv[8] = {lo_bf(lw.x), hi_bf(lw.x), lo_bf(lw.y), hi_bf(lw.y), lo_bf(lw.z), hi_bf(lw.z), lo_bf(lw.w), hi_bf(lw.w)}; \
                const float iv[8] = {lo_bf(iw.x), hi_bf(iw.x), lo_bf(iw.y), hi_bf(iw.y), lo_bf(iw.z), hi_bf(iw.z), lo_bf(iw.w), hi_bf(iw.w)}; \
                _Pragma("unroll") for (int q = 0; q < 8; ++q) { const float a = fexp2(lv[q] * LOG2E); const float mult = sqrtf(fmaxf(1.0f - a * a, 0.f)); hst[q] = a * hst[q] + mult * iv[q]; if (PASS == 1) ap[q] *= a; } \
                if (PASS == 2) { const u32x4 gw = gw##X[j]; \
                    u32x4 o; o.x = cvt_pk_bf16(hst[0] * lo_bf(gw.x), hst[1] * hi_bf(gw.x)); o.y = cvt_pk_bf16(hst[2] * lo_bf(gw.y), hst[3] * hi_bf(gw.y)); \
                    o.z = cvt_pk_bf16(hst[4] * lo_bf(gw.z), hst[5] * hi_bf(gw.z)); o.w = cvt_pk_bf16(hst[6] * lo_bf(gw.w), hst[7] * hi_bf(gw.w)); \
                    *(u32x4*)(y + (t0 + (s0) + j) * 1024 + c8) = o; } } } while (0)
        static_assert(CHUNK == 43, "scan batching below is written for 43-step chunks: 10 x 4 + 3");
        SCAN_LD(A, 4, 0);
#define SCAN_BODY(s0) do { SCAN_LD(B, 4, (s0) + 4); FENCE(); SCAN_CP(A, 4, (s0)); FENCE(); if ((s0) + 8 < 40) SCAN_LD(A, 4, (s0) + 8); else SCAN_LD(A, 3, 40); FENCE(); SCAN_CP(B, 4, (s0) + 4); FENCE(); } while (0)
        if (PASS == 2) {
            SCAN_BODY(0); SCAN_BODY(8); SCAN_BODY(16); SCAN_BODY(24); SCAN_BODY(32);
        } else {
#pragma unroll 1
            for (int s0 = 0; s0 < 40; s0 += 8) SCAN_BODY(s0);
        }
#undef SCAN_BODY
        SCAN_CP(A, 3, 40);
#undef SCAN_LD
#undef SCAN_CP
        if (PASS == 1) { float* ag = agg + ((size_t)(b * NCHUNK + ch) * 2) * 1024 + c8;
            *(f32x4*)ag = (f32x4){ap[0], ap[1], ap[2], ap[3]}; *(f32x4*)(ag + 4) = (f32x4){ap[4], ap[5], ap[6], ap[7]};
            *(f32x4*)(ag + 1024) = (f32x4){hst[0], hst[1], hst[2], hst[3]}; *(f32x4*)(ag + 1028) = (f32x4){hst[4], hst[5], hst[6], hst[7]}; }
    }
}

__global__ void __launch_bounds__(NTHREADS, 2) mega(Args args) {
    extern __shared__ __attribute__((aligned(16))) unsigned char lds_raw[];
    Frame F; F.lds = (LAS unsigned char*)lds_raw; F.tid = threadIdx.x; F.lane = F.tid & 63; F.wave = __builtin_amdgcn_readfirstlane(F.tid >> 6); F.G = gridDim.x; F.bid = blockIdx.x;
    F.in = args.in; F.out = args.out; F.ws = args.ws; F.ctl = (unsigned*)(args.ws + WS_CTL); F.dry = args.dry;
    volatile LAS unsigned* misc = (volatile LAS unsigned*)(F.lds + MISC_OFF);
    if (F.tid < 64) misc[F.tid] = 0u;
    __syncthreads();
    const int lo = args.ph_lo, hi = args.ph_hi;
    const bool multi = (hi - lo) > 1;
    XcdBarrier bar; bar.bar = F.ctl + CW_BAR; bar.x = 0; bar.st = misc;
    if (multi) bar = xcd_barrier_post(F.ctl + CW_BAR, misc);
#ifndef PHMASK
#define PHMASK 0xffff
#endif
#define IN(k) (((PHMASK >> (k)) & 1) && lo <= (k) && (k) < hi)
#define SEAM(k) do { if (IN(k) && IN((k) + 1)) xcd_barrier(bar); } while (0)
    LAS unsigned char* L = F.lds;
    if (IN(0)) { p0_prologue(F); } SEAM(0);
    if (IN(1)) { pg8::Gemm g{WSP(bf16_t, WS_RA), WSP(bf16_t, WS_WIN0), T, 768, 1024, 1024, 0, 0}; pg8::StaticOrder S; S.init(T, 768, F.G, F.bid);
        pg8::EpiBf16 E{WSP(bf16_t, WS_RB), 768}; pg8::gemm_phase(L, g, S, E);
        { const int n2 = P1_UNITS - F.G; const bool split = n2 > 0 && n2 + 32 < F.G;
          if (split && F.bid >= n2) { __syncthreads(); conv_tables(F, 16384, 2 * 16384, F.bid - n2, F.G - n2); } } } SEAM(1);
    if (IN(2)) { latnorm_phase(F); } SEAM(2);
    if (IN(3)) {
#ifndef P3SEL
#define P3SEL 7
#endif
        if (P3SEL & 1) { pg8::Gemm g{DOP(bf16_t, DO_QN), WSP(bf16_t, WS_WQUP), TMAIN, 1536, 384, 384, 0, 0}; pg8::StaticOrder S; S.init(TMAIN, 1536, F.G, F.bid);
          pg8::EpiBf16 E{WSP(bf16_t, WS_H), 1536}; pg8::gemm_phase(L, g, S, E); }
        if (P3SEL & 2) { pg8::Gemm g{DOP(bf16_t, DO_KVN), WSP(bf16_t, WS_WK), TMAIN, 1024, 256, 256, 0, 0}; pg8::StaticOrder S; S.init(TMAIN, 1024, F.G, F.bid);
          pg8::EpiBf16 E{DOP(bf16_t, DO_KN), 1024}; pg8::gemm_phase(L, g, S, E); }
        if (P3SEL & 4) { pg8::Gemm g{WSP(bf16_t, WS_WV), DOP(bf16_t, DO_KVN), 1024, TMAIN, 256, 256, 0, 0}; pg8::StaticOrder S; S.init(1024, TMAIN, F.G, F.bid);
          pg8::EpiBf16 E{WSP(bf16_t, WS_RB + U1), T}; pg8::gemm_phase(L, g, S, E); }
        { const int kq = F.lane >> 4, l15 = F.lane & 15;
          { bf16_t* o = WSP(bf16_t, WS_H) + (size_t)TMAIN * 1536;
            mini_gemm<384>(F, DOP(bf16_t, DO_QN) + (size_t)TMAIN * 384, 384, WSP(bf16_t, WS_WQUP), 384, 384, TREM / 16, 1536 / 16, [](int) { return 0; }, [=](int rt, int ct, f32x4 a) {
#pragma unroll
                for (int i = 0; i < 4; ++i) o[(size_t)(rt * 16 + 4 * kq + i) * 1536 + ct * 16 + l15] = f2bf(a[i]); }); }
          { bf16_t* o = DOP(bf16_t, DO_KN) + (size_t)TMAIN * 1024;
            mini_gemm<256>(F, DOP(bf16_t, DO_KVN) + (size_t)TMAIN * 256, 256, WSP(bf16_t, WS_WK), 256, 256, TREM / 16, 1024 / 16, [](int) { return 0; }, [=](int rt, int ct, f32x4 a) {
#pragma unroll
                for (int i = 0; i < 4; ++i) o[(size_t)(rt * 16 + 4 * kq + i) * 1024 + ct * 16 + l15] = f2bf(a[i]); }); }
          { bf16_t* o = WSP(bf16_t, WS_RB + U1) + TMAIN;
            mini_gemm<256>(F, WSP(bf16_t, WS_WV), 256, DOP(bf16_t, DO_KVN) + (size_t)TMAIN * 256, 256, 256, 1024 / 16, TREM / 16, [](int) { return 0; }, [=](int rt, int ct, f32x4 a) {
#pragma unroll
                for (int i = 0; i < 4; ++i) o[(size_t)(rt * 16 + 4 * kq + i) * T + ct * 16 + l15] = f2bf(a[i]); }); } }
    } SEAM(3);
    if (IN(4)) { attn_phase(F); } SEAM(4);
    if (IN(5)) { pg8::Gemm g{WSP(bf16_t, WS_RA), WSP(bf16_t, WS_WOUT0), TMAIN, 1024, 1024, 1024, 0, 0}; pg8::StaticOrder S; S.init(TMAIN, 1024, F.G, F.bid);
        pg8::EpiResX E{WSP(bf16_t, WS_H), F.in[0], F.in[2]}; pg8::gemm_phase(L, g, S, E);
        { bf16_t* hh_ = WSP(bf16_t, WS_H); const int kq = F.lane >> 4, l15 = F.lane & 15; const Frame Fc = F;
          mini_gemm<512>(F, WSP(bf16_t, WS_RA) + (size_t)TMAIN * 1024, 1024, WSP(bf16_t, WS_WOUT0), 1024, 1024, TREM / 16, 1024 / 16, [](int) { return 0; }, [=](int rt, int ct, f32x4 a) {
#pragma unroll
              for (int i = 0; i < 4; ++i) { const int t = TMAIN + rt * 16 + 4 * kq + i, c = ct * 16 + l15; hh_[(size_t)t * 1024 + c] = f2bf(h0_row(Fc, t)[c] + a[i]); } }); } } SEAM(5);
    if (IN(6)) { pg8::Gemm g{WSP(bf16_t, WS_H), WSP(bf16_t, WS_WPQ), TMAIN, 2048, 1024, 1024, 0, 0}; pg8::StaticOrder S; S.init(TMAIN, 2048, F.G, F.bid);
        pg8::EpiBf16 E{WSP(bf16_t, WS_RB), 2048}; pg8::gemm_phase(L, g, S, E);
        { bf16_t* o = WSP(bf16_t, WS_RB) + (size_t)TMAIN * 2048; const int kq = F.lane >> 4, l15 = F.lane & 15;
          mini_gemm<512>(F, WSP(bf16_t, WS_H) + (size_t)TMAIN * 1024, 1024, WSP(bf16_t, WS_WPQ), 1024, 1024, TREM / 16, 2048 / 16, [](int) { return 0; }, [=](int rt, int ct, f32x4 a) {
#pragma unroll
              for (int i = 0; i < 4; ++i) o[(size_t)(rt * 16 + 4 * kq + i) * 2048 + ct * 16 + l15] = f2bf(a[i]); }); } } SEAM(6);
    if (IN(7)) { peer_phase<false>(F, 0); } SEAM(7);
    if (IN(8)) { pg8::Gemm g{WSP(bf16_t, WS_H2), WSP(bf16_t, WS_WLIN), TMAIN, 2048, 1024, 1024, 0, 0}; pg8::StaticOrder S; S.init(TMAIN, 2048, F.G, F.bid);
        pg8::EpiLruIn E{WSP(bf16_t, WS_RB), WSP(bf16_t, WS_RB + U1), WSP(float, WS_RS2)}; pg8::gemm_phase(L, g, S, E);
        { bf16_t* og = WSP(bf16_t, WS_RB) + (size_t)TMAIN * 1024; bf16_t* ox = WSP(bf16_t, WS_RB + U1) + (size_t)TMAIN * 1024; const float* rsr = WSP(float, WS_RS2) + TMAIN; const int kq = F.lane >> 4, l15 = F.lane & 15;
          mini_gemm<512>(F, WSP(bf16_t, WS_H2) + (size_t)TMAIN * 1024, 1024, WSP(bf16_t, WS_WLIN), 1024, 1024, TREM / 16, 2048 / 16, [](int) { return 0; }, [=](int rt, int ct, f32x4 a) {
              const int c = ct * 16 + l15;
#pragma unroll
              for (int i = 0; i < 4; ++i) { const int rr = rt * 16 + 4 * kq + i; const size_t ro = (size_t)rr * 1024; const float v = a[i] * rsr[rr]; if (c < 1024) og[ro + c] = f2bf(gelu_tanh(v)); else ox[ro + c - 1024] = f2bf(v); } }); } } SEAM(8);
    if (IN(9)) { conv_phase(F); } SEAM(9);
    if (IN(10)) { pg8::Gemm g{WSP(bf16_t, WS_RA), WSP(bf16_t, WS_WGATE), TMAIN, 2048, 256, 1024, 1, 256}; pg8::StaticOrder S; S.init(TMAIN, 2048, F.G, F.bid);
        pg8::EpiGate E{DOP(bf16_t, 0), WSP(bf16_t, WS_RB + U1), WSP(bf16_t, WS_RA), WSP(float, WS_LRUC)}; pg8::gemm_phase<pg8::EpiGate, false, false>(L, g, S, E);
        { bf16_t* ola = DOP(bf16_t, 0) + (size_t)TMAIN * 1024; bf16_t* oix = WSP(bf16_t, WS_RB + U1) + (size_t)TMAIN * 1024; const bf16_t* xcp = WSP(bf16_t, WS_RA) + (size_t)TMAIN * 1024;
          const float* lc = WSP(float, WS_LRUC); const int kq = F.lane >> 4, l15 = F.lane & 15;
          mini_gemm<256>(F, xcp, 1024, WSP(bf16_t, WS_WGATE), 256, 256, TREM / 16, 2048 / 16, [](int ct) { return 256 * ((ct >> 4) >> 1); }, [=](int rt, int ct, f32x4 a) {
              const int j = ct >> 4, cl = (ct & 15) * 16 + l15, e = cl & 127, ch = j * 128 + e; const bool isx = cl >= 128;
#pragma unroll
              for (int i = 0; i < 4; ++i) { const size_t ro = (size_t)(rt * 16 + 4 * kq + i) * 1024 + ch;
                  if (isx) oix[ro] = f2bf(sigmoidf_(a[i] + lc[1024 + ch]) * bf2f(xcp[ro])); else ola[ro] = f2bf(-lc[2048 + ch] * sigmoidf_(a[i] + lc[ch])); } }); } } SEAM(10);
    if (IN(11)) { scan_phase<1>(F); } SEAM(11);
    if (IN(12)) { scan_phase<2>(F); } SEAM(12);
    if (IN(13)) { pg8::Gemm g{WSP(bf16_t, WS_RA), WSP(bf16_t, WS_WLOUT), TMAIN, 1024, 1024, 1024, 0, 0}; pg8::StaticOrder S; S.init(TMAIN, 1024, F.G, F.bid);
        const float rsc = F.dry ? 0.0f : 1.0f;
        pg8::EpiResB E{WSP(bf16_t, WS_H), WSP(bf16_t, WS_H2), rsc}; pg8::gemm_phase(L, g, S, E);
        { bf16_t* hh_ = WSP(bf16_t, WS_H) + (size_t)TMAIN * 1024; const bf16_t* hb_ = WSP(bf16_t, WS_H2) + (size_t)TMAIN * 1024; const int kq = F.lane >> 4, l15 = F.lane & 15;
          mini_gemm<512>(F, WSP(bf16_t, WS_RA) + (size_t)TMAIN * 1024, 1024, WSP(bf16_t, WS_WLOUT), 1024, 1024, TREM / 16, 1024 / 16, [](int) { return 0; }, [=](int rt, int ct, f32x4 a) {
#pragma unroll
              for (int i = 0; i < 4; ++i) { const size_t o_ = (size_t)(rt * 16 + 4 * kq + i) * 1024 + ct * 16 + l15; hh_[o_] = f2bf(bf2f(hb_[o_]) + a[i] * rsc); } }); } } SEAM(13);
    if (IN(14)) { pg8::Gemm g{WSP(bf16_t, WS_H), WSP(bf16_t, WS_WPQ) + (size_t)2048 * 1024, TMAIN, 2048, 1024, 1024, 0, 0}; pg8::StaticOrder S; S.init(TMAIN, 2048, F.G, F.bid);
        pg8::EpiBf16 E{WSP(bf16_t, WS_RB), 2048}; pg8::gemm_phase(L, g, S, E);
        { bf16_t* o = WSP(bf16_t, WS_RB) + (size_t)TMAIN * 2048; const int kq = F.lane >> 4, l15 = F.lane & 15;
          mini_gemm<512>(F, WSP(bf16_t, WS_H) + (size_t)TMAIN * 1024, 1024, WSP(bf16_t, WS_WPQ) + (size_t)2048 * 1024, 1024, 1024, TREM / 16, 2048 / 16, [](int) { return 0; }, [=](int rt, int ct, f32x4 a) {
#pragma unroll
              for (int i = 0; i < 4; ++i) o[(size_t)(rt * 16 + 4 * kq + i) * 2048 + ct * 16 + l15] = f2bf(a[i]); }); } } SEAM(14);
    if (IN(15)) { peer_phase<true>(F, 1); }
#undef IN
#undef SEAM
}

#ifndef MK_ONE_LAUNCH
#define MK_ONE_LAUNCH 1
#endif
#ifndef PROBE_DUP
#define PROBE_DUP 0
#endif
extern "C" void kernel_launch(void* const* d_in, const int* in_sizes, int n_in, void* d_out, int out_size, void* d_ws, size_t ws_size, hipStream_t stream) {
    static int grid = 0;
    if (grid == 0) {
        if (n_in != 25 || out_size != BATCH * SEQ * D || ws_size < WS_END) { fprintf(stderr, "kernel_launch: unexpected shapes (n_in %d out %d ws %zu need %zu)\n", n_in, out_size, ws_size, (size_t)WS_END); grid = -1; return; }
        int dev = 0, cus = 0, per_cu = 0;
        if (hipGetDevice(&dev) != hipSuccess || hipDeviceGetAttribute(&cus, hipDeviceAttributeMultiprocessorCount, dev) != hipSuccess) { grid = -1; return; }
        if (hipFuncSetAttribute((const void*)mega, hipFuncAttributeMaxDynamicSharedMemorySize, LDS_BYTES) != hipSuccess) { fprintf(stderr, "kernel_launch: hipFuncSetAttribute failed\n"); grid = -1; return; }
        if (hipOccupancyMaxActiveBlocksPerMultiprocessor(&per_cu, (const void*)mega, NTHREADS, LDS_BYTES) != hipSuccess || per_cu < 1) { fprintf(stderr, "kernel_launch: occupancy query says %d\n", per_cu); }
        (void)hipGetLastError();
        grid = cus;
    }
    if (grid < 0) return;
    (void)hipMemsetAsync((char*)d_ws + WS_CTL, 0, CTL_BYTES, stream);
    Args a{};
    for (int i = 0; i < 25; ++i) a.in[i] = (const float*)d_in[i];
    a.out = (float*)d_out; a.ws = (unsigned char*)d_ws;
#if MK_ONE_LAUNCH
    a.ph_lo = 0; a.ph_hi = NPHASE;
    hipLaunchKernelGGL(mega, dim3(grid), dim3(NTHREADS), LDS_BYTES, stream, a);
#else
    for (int p = 0; p < NPHASE; ++p) { a.ph_lo = p; a.ph_hi = p + 1;
        if ((PROBE_DUP >> p) & 1) { a.dry = 1; hipLaunchKernelGGL(mega, dim3(grid), dim3(NTHREADS), LDS_BYTES, stream, a); }
        a.dry = 0; hipLaunchKernelGGL(mega, dim3(grid), dim3(NTHREADS), LDS_BYTES, stream, a); }
#endif
}
```

```cpp
#include <hip/hip_runtime.h>
#include <cstdio>
#include <cstdint>

#ifndef PAD_G
#define PAD_G "\n\ts_nop 0"
#endif
#ifndef PAD_M
#define PAD_M "\n\ts_nop 0"
#endif
#ifndef PAD_A
#define PAD_A "\n\ts_nop 0"
#endif
#ifndef PAD_P
#define PAD_P ""
#endif
#ifndef PAD_S
#define PAD_S "\n\ts_nop 0"
#endif
#define PLACE(pad_) asm volatile(".p2align 3" pad_)
#define LAS __attribute__((address_space(3)))
typedef unsigned short bf16_t;
typedef short bf16x8 __attribute__((ext_vector_type(8)));
typedef float f32x4 __attribute__((ext_vector_type(4)));
typedef float f32x16 __attribute__((ext_vector_type(16)));
typedef unsigned u32x4 __attribute__((ext_vector_type(4)));
typedef unsigned u32x2 __attribute__((ext_vector_type(2)));
typedef float f32x2 __attribute__((ext_vector_type(2)));
typedef __bf16 bf16x2_t __attribute__((ext_vector_type(2)));
typedef int i32x8 __attribute__((ext_vector_type(8)));
typedef _Float16 h2_t __attribute__((ext_vector_type(2)));
#define FENCE() asm volatile("" ::: "memory")
__device__ __forceinline__ float dot2bf(unsigned w, unsigned x, float acc) { return __builtin_amdgcn_fdot2_f32_bf16(__builtin_bit_cast(bf16x2_t, w), __builtin_bit_cast(bf16x2_t, x), acc, false); }

constexpr int BATCH = 16, SEQ = 2048, NMETA = 16, LTOK = SEQ + NMETA  , T = BATCH * LTOK  , D = 1024;
constexpr int NTHREADS = 512, NWAVES = 8;
constexpr int NCHUNK = 48, CHUNK = 43;
static_assert(NCHUNK * CHUNK == LTOK, "scan chunking");
constexpr float QSCALE = 0.07216878364870322f * 1.4426950408889634f;
constexpr float LOG2E = 1.4426950408889634f;
#ifndef U_FP4
#define U_FP4 1
#endif
#ifndef V_FP4
#define V_FP4 1
#endif
constexpr int U_ROWB = U_FP4 ? 512 : 1024, V_ROWB = V_FP4 ? 512 : 1024;

constexpr size_t U1 = (size_t)T * 1024 * 2;
constexpr size_t WS_CTL = 0;
constexpr size_t CTL_BYTES = 65536;
constexpr size_t WS_WIN0 = WS_CTL + CTL_BYTES;
constexpr size_t WS_WQUP = WS_WIN0 + 768 * 1024 * 2;
constexpr size_t WS_WK = WS_WQUP + 1536 * 384 * 2;
constexpr size_t WS_WV = WS_WK + 1024 * 256 * 2;
constexpr size_t WS_WOUT0 = WS_WV + 1024 * 256 * 2;
constexpr size_t WS_WLIN = WS_WOUT0 + 1024 * 1024 * 2;
constexpr size_t WS_WGATE = WS_WLIN + 2048 * 1024 * 2;
constexpr size_t WS_WLOUT = WS_WGATE + 2048 * 256 * 2;
constexpr size_t WS_WPQ = WS_WLOUT + 1024 * 1024 * 2;
constexpr size_t WS_KEYS = WS_WPQ + 2 * 2048 * 1024 * 2;
constexpr size_t WS_LRUC = WS_KEYS + 2 * 2 * 128 * 128 * 2;
constexpr size_t WS_ROPE = WS_LRUC + 3 * 1024 * 4;
constexpr size_t WS_AGG = WS_ROPE + (size_t)T * 32 * 2 * 4;
constexpr size_t WS_U = WS_AGG + (size_t)BATCH * NCHUNK * 2 * 1024 * 4;
constexpr size_t WS_V = WS_U + 2ull * 16384 * 1024;
constexpr size_t WS_USC = WS_V + 2ull * 16384 * 1024;
constexpr size_t WS_VSC = WS_USC + 2ull * 16384 * 4;
constexpr size_t WS_RS2 = WS_VSC + 2ull * 16384 * 4;
constexpr size_t WS_H = WS_RS2 + (size_t)T * 4 + 128;
constexpr size_t WS_RA = WS_H + 2 * U1;
constexpr size_t WS_RB = WS_RA + U1;
constexpr size_t WS_H2 = WS_RB + 2 * U1;
constexpr size_t WS_END = WS_H2 + U1;
static_assert(WS_END <= 512ull * 1024 * 1024, "workspace map exceeds 512 MiB");
constexpr size_t DO_KN = 0, DO_QN = U1, DO_KVN = DO_QN + (size_t)T * 384 * 2, DO_KPE = DO_KVN + (size_t)T * 256 * 2;
static_assert(DO_KPE + (size_t)T * 64 * 2 <= (size_t)BATCH * SEQ * D * 4, "d_out scratch map");

constexpr int CW_BAR = 0;
constexpr int CW_ATTN = 4096;

__device__ __forceinline__ float bf2f(unsigned short b) { return __uint_as_float(((unsigned)b) << 16); }
__device__ __forceinline__ unsigned cvt_pk_bf16(float lo, float hi) { bf16x2_t v; v.x = (__bf16)lo; v.y = (__bf16)hi; return __builtin_bit_cast(unsigned, v); }
__device__ __forceinline__ float fexp2(float x) { return __builtin_amdgcn_exp2f(x); }
__device__ __forceinline__ float frcp(float x) { return __builtin_amdgcn_rcpf(x); }
__device__ __forceinline__ float sigmoidf_(float z) { return frcp(1.0f + fexp2(-z * LOG2E)); }
__device__ __forceinline__ float gelu_tanh(float x) { const float u = 0.7978845608028654f * (x + 0.044715f * x * x * x); return x * frcp(1.0f + fexp2(-2.0f * LOG2E * u)); }
__device__ __forceinline__ float lo_bf(unsigned w) { return __uint_as_float(w << 16); }
__device__ __forceinline__ float hi_bf(unsigned w) { return __uint_as_float(w & 0xffff0000u); }
__device__ __forceinline__ float wave_sum(float v) {
    v += __uint_as_float((unsigned)__builtin_amdgcn_update_dpp(0, (int)__float_as_uint(v), 0x128, 0xf, 0xf, false));
    v += __uint_as_float((unsigned)__builtin_amdgcn_update_dpp(0, (int)__float_as_uint(v), 0x124, 0xf, 0xf, false));
    v += __uint_as_float((unsigned)__builtin_amdgcn_update_dpp(0, (int)__float_as_uint(v), 0x122, 0xf, 0xf, false));
    v += __uint_as_float((unsigned)__builtin_amdgcn_update_dpp(0, (int)__float_as_uint(v), 0x121, 0xf, 0xf, false));
    { const auto r = __builtin_amdgcn_permlane16_swap(__float_as_uint(v), __float_as_uint(v), false, false); v = __uint_as_float(r[0]) + __uint_as_float(r[1]); }
    { const auto r = __builtin_amdgcn_permlane32_swap(__float_as_uint(v), __float_as_uint(v), false, false); v = __uint_as_float(r[0]) + __uint_as_float(r[1]); }
    return v;
}

#define XB_TMO      128
#define XB_XCNT(j)  (256  + 64 * (j))
#define XB_XSUB(j)  (1280 + 64 * (j))
#define XB_XGEN(j)  (2304 + 64 * (j))
#define XB_TOP      3328
#define XB_TOPGEN   3392
#define XCD_BAR_WORDS 3456
#define XB_SPIN_CAP (1u << 18)
__device__ __forceinline__ unsigned xb_ld(unsigned* p)              { return __hip_atomic_load(p, __ATOMIC_RELAXED, __HIP_MEMORY_SCOPE_AGENT); }
__device__ __forceinline__ unsigned xb_add(unsigned* p, unsigned v) { return __hip_atomic_fetch_add(p, v, __ATOMIC_RELAXED, __HIP_MEMORY_SCOPE_AGENT); }
__device__ __forceinline__ unsigned xb_xcc_id() { return (unsigned)__builtin_amdgcn_s_getreg((3 << 11) | 20) & 0xFu; }
#define XB_SPIN(cond, bar) do { unsigned _sp = 0; while (cond) { __builtin_amdgcn_s_sleep(1); \
    if ((++_sp & 255u) == 0u) { if (xb_ld(&(bar)[XB_TMO])) break; if (_sp > XB_SPIN_CAP) { atomicAdd(&(bar)[XB_TMO], 1u); break; } } } } while (0)
struct XcdBarrier { unsigned* bar; unsigned x; volatile LAS unsigned* st; };
__device__ __forceinline__ XcdBarrier xcd_barrier_post(unsigned* bar, volatile LAS unsigned* st) {
    XcdBarrier b; b.bar = bar; b.x = xb_xcc_id(); b.st = st;
    if (threadIdx.x == 0) (void)xb_add(&bar[XB_XCNT(b.x)], 1u);
    return b;
}
__device__ __forceinline__ void xcd_barrier_complete(unsigned* bar, unsigned x, unsigned& nloc, unsigned& nx) {
    const unsigned G = gridDim.x * gridDim.y * gridDim.z;
    unsigned sum, cnt, mine, sp = 0u;
    for (;;) {
        sum = 0u; cnt = 0u; mine = 0u;
#pragma unroll
        for (unsigned j = 0; j < 16; ++j) { const unsigned c = xb_ld(&bar[XB_XCNT(j)]); sum += c; cnt += (c > 0u) ? 1u : 0u; mine = (j == x) ? c : mine; }
        if (sum == G) break;
        __builtin_amdgcn_s_sleep(1);
        if ((++sp & 255u) == 0u) { if (xb_ld(&bar[XB_TMO])) break; if (sp > XB_SPIN_CAP) { atomicAdd(&bar[XB_TMO], 1u); break; } }
    }
    nloc = mine > 0u ? mine : 1u; nx = cnt > 0u ? cnt : 1u;
}
__device__ __forceinline__ void xcd_barrier(const XcdBarrier& b) {
    asm volatile("s_waitcnt vmcnt(0)" ::: "memory");
    __syncthreads();
    if (threadIdx.x == 0) {
        unsigned* bar = b.bar;
        __builtin_amdgcn_s_waitcnt(0);
        unsigned nloc = b.st[0], nx = b.st[1];
        if (nloc == 0u) { xcd_barrier_complete(bar, b.x, nloc, nx); b.st[0] = nloc; b.st[1] = nx; }
        const unsigned old = xb_add(&bar[XB_XSUB(b.x)], 1u);
        const unsigned gen = old / nloc;
        if (old + 1u == (gen + 1u) * nloc) {
            __builtin_amdgcn_fence(__ATOMIC_RELEASE, "agent");
            asm volatile("s_waitcnt vmcnt(0)" ::: "memory");
            const unsigned og = xb_add(&bar[XB_TOP], 1u);
            const unsigned tg = og / nx;
            if (og + 1u == (tg + 1u) * nx) xb_add(&bar[XB_TOPGEN], 1u);
            else XB_SPIN(xb_ld(&bar[XB_TOPGEN]) == tg, bar);
            __builtin_amdgcn_fence(__ATOMIC_ACQUIRE, "agent");
            xb_add(&bar[XB_XGEN(b.x)], 1u);
            asm volatile("s_waitcnt vmcnt(0)" ::: "memory");
        } else {
            XB_SPIN(xb_ld(&bar[XB_XGEN(b.x)]) == gen, bar);
            __builtin_amdgcn_fence(__ATOMIC_ACQUIRE, "agent");
            asm volatile("s_waitcnt vmcnt(0)" ::: "memory");
        }
    }
    __syncthreads();
}

namespace pg8 {
constexpr int BM = 256, BK = 64, HALF = 128, HTB = HALF * BK * 2, STAGE_BYTES = 8 * HTB, NXCD = 8, WGM = 8;
__host__ __device__ __forceinline__ int lds_byte(int r, int c) { const int st = (r >> 4) * 2 + (c >> 5), rr = r & 15, cc = c & 31, ob = rr * 64 + cc * 2; return st * 1024 + (ob ^ (((ob >> 9) & 1) << 5)); }
__host__ __device__ __forceinline__ void stage_rc(int b, int& R, int& C) { const int st = b / 1024, sb = b % 1024, swz = sb ^ (((sb >> 9) & 1) << 5); R = (st >> 1) * 16 + swz / 64; C = (st & 1) * 32 + (swz % 64) / 2; }
__host__ __device__ __forceinline__ int perm32(int rho) { const int n = rho >> 4, i = rho & 15; return 8 * (i >> 2) + 4 * n + (i & 3); }
struct Unit { int pm, pn; };
struct Gemm { const bf16_t* A; const bf16_t* Bt; int M, N, K, lda, a_sh, a_cols; };
struct StaticOrder {
    int nM, nN, nwg, G, c;
    __device__ void init(int M, int N, int G_, int c_) { nM = M / BM; nN = N / BM; nwg = nM * nN; G = G_; c = c_; }
    __device__ bool next(int i, Unit& u) const {
        const long L = (long)i * G + c; if (L >= nwg) return false;
        int wgid = (int)L; { const int q = nwg / NXCD, r = nwg % NXCD, xcd = wgid % NXCD, off = wgid / NXCD; wgid = (xcd < r ? xcd * (q + 1) : r * (q + 1) + (xcd - r) * q) + off; }
        const int nig = WGM * nN, gid = wgid / nig, fm = gid * WGM, gsz = (nM - fm) < WGM ? (nM - fm) : WGM;
        u.pm = fm + ((wgid % nig) % gsz); u.pn = (wgid % nig) / gsz; return true;
    }
};

template <class Epi, bool ALIGN_EPI = true, bool SP2 = true>
__device__ __forceinline__ void gemm_phase(LAS unsigned char* lds, const Gemm g, const StaticOrder& S, const Epi& E) {
    PLACE(PAD_G);
    const int tid = threadIdx.x, wid = __builtin_amdgcn_readfirstlane(tid >> 6), lane = tid & 63, wr = wid >> 2, wc = wid & 3, fr = lane & 15, fq = lane >> 4;
    const int K = g.K, nt = K / BK, lda = g.lda;
    unsigned voffA[2], voffB[2];
#pragma unroll
    for (int i = 0; i < 2; ++i) { int R, C; stage_rc(tid * 16 + i * 8192, R, C); const int Rb = Epi::PERM ? ((R & ~31) + perm32(R & 31)) : R;
        voffA[i] = (unsigned)(R * lda + C) * 2u; voffB[i] = (unsigned)(Rb * K + C) * 2u; }
    const size_t kstep = (size_t)(BK * 2);
    const size_t hstepA = (size_t)HALF * lda * 2, tstepA = 2 * hstepA;
    const size_t hstepB = (size_t)HALF * K * 2, tstepB = 2 * hstepB;
    const unsigned ldsw = (unsigned)wid * 1024u;
    const int aoff = lds_byte(wr * 64 + fr, fq * 8), boff = lds_byte(wc * 32 + fr, fq * 8);
#define PG8_SA(b, h) (((b) * 2 + (h)) * HTB)
#define PG8_SB(b, h) ((4 + (b) * 2 + (h)) * HTB)
#define PG8_STAGE(bufoff, gbase, voff) do { _Pragma("unroll") for (int _i = 0; _i < 2; ++_i) \
        __builtin_amdgcn_global_load_lds((const unsigned*)((const char*)(gbase) + (voff)[_i]), (LAS unsigned*)(lds + (bufoff) + ldsw + _i * 8192), 16, 0, 0); } while (0)
#define PG8_LDA(dst, b, h) do { _Pragma("unroll") for (int m = 0; m < 4; ++m) _Pragma("unroll") for (int k = 0; k < 2; ++k) dst[m][k] = *(const LAS bf16x8*)(lds + PG8_SA(b, h) + aoff + m * 2048 + k * 1024); } while (0)
#define PG8_LDB(dst, b, h) do { _Pragma("unroll") for (int n = 0; n < 2; ++n) _Pragma("unroll") for (int k = 0; k < 2; ++k) dst[n][k] = *(const LAS bf16x8*)(lds + PG8_SB(b, h) + boff + n * 2048 + k * 1024); } while (0)
#define PG8_MMA(ai, bj, At, Bt) do { __builtin_amdgcn_s_setprio(1); _Pragma("unroll") for (int m = 0; m < 4; ++m) _Pragma("unroll") for (int n = 0; n < 2; ++n) _Pragma("unroll") for (int k = 0; k < 2; ++k) \
        acc[ai][bj][m][n] = __builtin_amdgcn_mfma_f32_16x16x32_bf16(Bt[n][k], At[m][k], acc[ai][bj][m][n], 0, 0, 0); __builtin_amdgcn_s_setprio(0); } while (0)
#define PG8_WAIT_V(n) asm volatile("s_waitcnt vmcnt(" #n ")" ::: "memory")
#define PG8_WAIT_L(n) asm volatile("s_waitcnt lgkmcnt(" #n ")" ::: "memory")
#define PG8_BAR __builtin_amdgcn_s_barrier()
#define PG8_SCHED __builtin_amdgcn_sched_barrier(0)
#define PG8_UA(u_) ((const char*)g.A + (size_t)(u_).pm * tstepA + (size_t)(((u_).pn >> g.a_sh) * g.a_cols) * 2)
    Unit cur, nxt; int ui = 0;
    if (!S.next(0, cur)) return;
    f32x4 acc[2][2][4][2];
#pragma unroll
    for (int a = 0; a < 2; ++a)
#pragma unroll
        for (int b = 0; b < 2; ++b)
#pragma unroll
            for (int m = 0; m < 4; ++m)
#pragma unroll
                for (int n = 0; n < 2; ++n) acc[a][b][m][n] = (f32x4){0.f, 0.f, 0.f, 0.f};
    bf16x8 At[4][2], B0[2][2], B1[2][2];
    const char* cA = PG8_UA(cur); const char* cB = (const char*)g.Bt + (size_t)cur.pn * tstepB;
    if constexpr (SP2) {
        PG8_STAGE(PG8_SB(0, 0), cB, voffB); PG8_STAGE(PG8_SB(0, 1), cB + hstepB, voffB); PG8_STAGE(PG8_SA(0, 0), cA, voffA); PG8_STAGE(PG8_SA(0, 1), cA + hstepA, voffA);
        if (wr == 1) PG8_BAR;
        PG8_WAIT_V(2); PG8_BAR;
        PG8_STAGE(PG8_SB(1, 0), cB + kstep, voffB); PG8_STAGE(PG8_SA(1, 0), cA + kstep, voffA); PG8_STAGE(PG8_SB(1, 1), cB + hstepB + kstep, voffB);
        PG8_WAIT_V(6); PG8_BAR;
    } else {
        PG8_STAGE(PG8_SB(0, 0), cB, voffB); PG8_STAGE(PG8_SA(0, 0), cA, voffA); PG8_STAGE(PG8_SB(0, 1), cB + hstepB, voffB); PG8_STAGE(PG8_SA(0, 1), cA + hstepA, voffA);
        if (wr == 1) PG8_BAR;
        PG8_WAIT_V(4); PG8_BAR;
        PG8_STAGE(PG8_SB(1, 0), cB + kstep, voffB); PG8_STAGE(PG8_SA(1, 0), cA + kstep, voffA); PG8_STAGE(PG8_SB(1, 1), cB + hstepB + kstep, voffB);
        PG8_WAIT_V(6); PG8_BAR;
    }
    for (;;) {
        const bool has_next = S.next(ui + 1, nxt);
        const char* nA = has_next ? PG8_UA(nxt) : cA; const char* nB = has_next ? (const char*)g.Bt + (size_t)nxt.pn * tstepB : cB;
        for (int t = 0; t < nt; t += 2) {
            const bool last = (t == nt - 2);
            const char* a1 = cA + (size_t)(t + 1) * kstep;
            const char* a2 = last ? nA : cA + (size_t)(t + 2) * kstep; const char* b2 = last ? nB : cB + (size_t)(t + 2) * kstep;
            const char* a3 = a2 + kstep; const char* b3 = b2 + kstep;
            if constexpr (SP2) {
            PG8_LDB(B0, 0, 0); PG8_LDB(B1, 0, 1); PG8_SCHED; PG8_LDA(At, 0, 0); PG8_STAGE(PG8_SA(1, 1), a1 + hstepA, voffA);
            PG8_WAIT_V(8); PG8_WAIT_L(0); PG8_BAR; PG8_MMA(0, 0, At, B0); PG8_MMA(0, 1, At, B1); PG8_BAR; PG8_SCHED;
            PG8_LDA(At, 0, 1); PG8_STAGE(PG8_SB(0, 0), b2, voffB); PG8_STAGE(PG8_SB(0, 1), b2 + hstepB, voffB); PG8_STAGE(PG8_SA(0, 0), a2, voffA);
            PG8_WAIT_V(8); PG8_WAIT_L(0); PG8_BAR; PG8_MMA(1, 0, At, B0); PG8_MMA(1, 1, At, B1); PG8_BAR; PG8_SCHED;
            PG8_LDB(B0, 1, 0); PG8_LDB(B1, 1, 1); PG8_SCHED; PG8_LDA(At, 1, 0); PG8_STAGE(PG8_SA(0, 1), a2 + hstepA, voffA);
            PG8_WAIT_V(8); PG8_WAIT_L(0); PG8_BAR; PG8_MMA(0, 0, At, B0); PG8_MMA(0, 1, At, B1); PG8_BAR; PG8_SCHED;
            PG8_LDA(At, 1, 1); PG8_STAGE(PG8_SB(1, 0), b3, voffB); PG8_STAGE(PG8_SB(1, 1), b3 + hstepB, voffB); PG8_STAGE(PG8_SA(1, 0), a3, voffA);
            PG8_WAIT_V(8); PG8_WAIT_L(0); PG8_BAR; PG8_MMA(1, 0, At, B0); PG8_MMA(1, 1, At, B1); PG8_BAR; PG8_SCHED;
            } else {
            PG8_LDB(B0, 0, 0); PG8_SCHED; PG8_LDA(At, 0, 0); PG8_STAGE(PG8_SA(1, 1), a1 + hstepA, voffA);
            PG8_WAIT_L(8); PG8_BAR; PG8_WAIT_L(0); PG8_MMA(0, 0, At, B0); PG8_BAR; PG8_SCHED;
            PG8_LDB(B1, 0, 1); PG8_STAGE(PG8_SB(0, 0), b2, voffB);
            PG8_BAR; PG8_WAIT_L(0); PG8_MMA(0, 1, At, B1); PG8_BAR;
            PG8_LDA(At, 0, 1); PG8_STAGE(PG8_SA(0, 0), a2, voffA);
            PG8_BAR; PG8_WAIT_L(0); PG8_MMA(1, 0, At, B0); PG8_BAR; PG8_SCHED;
            PG8_STAGE(PG8_SB(0, 1), b2 + hstepB, voffB);
            PG8_WAIT_V(6); PG8_BAR; PG8_MMA(1, 1, At, B1); PG8_BAR;
            PG8_LDB(B0, 1, 0); PG8_SCHED; PG8_LDA(At, 1, 0); PG8_STAGE(PG8_SA(0, 1), a2 + hstepA, voffA);
            PG8_WAIT_L(8); PG8_BAR; PG8_WAIT_L(0); PG8_MMA(0, 0, At, B0); PG8_BAR; PG8_SCHED;
            PG8_LDB(B1, 1, 1); PG8_STAGE(PG8_SB(1, 0), b3, voffB);
            PG8_BAR; PG8_WAIT_L(0); PG8_MMA(0, 1, At, B1); PG8_BAR;
            PG8_LDA(At, 1, 1); PG8_STAGE(PG8_SA(1, 0), a3, voffA);
            PG8_BAR; PG8_WAIT_L(0); PG8_MMA(1, 0, At, B0); PG8_BAR; PG8_SCHED;
            PG8_STAGE(PG8_SB(1, 1), b3 + hstepB, voffB);
            PG8_WAIT_V(6); PG8_BAR; PG8_MMA(1, 1, At, B1); PG8_BAR;
            }
        }
        if constexpr (ALIGN_EPI) { if (wr == 0) PG8_BAR; }
        E(acc, cur, wr, wc, fr, fq);
        if (!has_next) break;
#pragma unroll
        for (int a = 0; a < 2; ++a)
#pragma unroll
            for (int b = 0; b < 2; ++b)
#pragma unroll
                for (int m = 0; m < 4; ++m)
#pragma unroll
                    for (int n = 0; n < 2; ++n) acc[a][b][m][n] = (f32x4){0.f, 0.f, 0.f, 0.f};
        cur = nxt; cA = nA; cB = nB; ++ui;
        if constexpr (ALIGN_EPI) { if (wr == 1) PG8_BAR; }
    }
    PG8_WAIT_V(0);
    if constexpr (!ALIGN_EPI) { if (wr == 0) PG8_BAR; }
    PG8_BAR;
#undef PG8_UA
#undef PG8_SA
#undef PG8_SB
#undef PG8_STAGE
#undef PG8_LDA
#undef PG8_LDB
#undef PG8_MMA
#undef PG8_WAIT_V
#undef PG8_WAIT_L
#undef PG8_BAR
#undef PG8_SCHED
}

typedef const f32x4 (&AccRef)[2][2][4][2];

struct EpiBf16 {
    static constexpr bool PERM = true;
    bf16_t* O; int ldc;
    __device__ __forceinline__ void operator()(AccRef acc, const Unit& u, int wr, int wc, int fr, int fq) const {
        const int row0 = u.pm * BM + wr * 64 + fr, col0 = u.pn * BM + wc * 32 + 8 * fq;
#pragma unroll
        for (int ai = 0; ai < 2; ++ai)
#pragma unroll
            for (int m = 0; m < 4; ++m) { bf16_t* rowp = O + (size_t)(row0 + ai * HALF + m * 16) * ldc + col0;
#pragma unroll
                for (int bj = 0; bj < 2; ++bj) { const f32x4 v0 = acc[ai][bj][m][0], v1 = acc[ai][bj][m][1];
                    u32x4 w; w.x = cvt_pk_bf16(v0[0], v0[1]); w.y = cvt_pk_bf16(v0[2], v0[3]); w.z = cvt_pk_bf16(v1[0], v1[1]); w.w = cvt_pk_bf16(v1[2], v1[3]);
                    *(u32x4*)(rowp + bj * HALF) = w; } }
    }
};
struct EpiLruIn {
    static constexpr bool PERM = true;
    bf16_t* G; bf16_t* X; const float* rs;
    __device__ __forceinline__ void operator()(AccRef acc, const Unit& u, int wr, int wc, int fr, int fq) const {
        const int row0 = u.pm * BM + wr * 64 + fr; const bool isg = u.pn < 4; const int col0 = (u.pn & 3) * BM + wc * 32 + 8 * fq; bf16_t* base = isg ? G : X;
        float rss[2][4];
#pragma unroll
        for (int ai = 0; ai < 2; ++ai)
#pragma unroll
            for (int m = 0; m < 4; ++m) rss[ai][m] = rs[row0 + ai * HALF + m * 16];
        FENCE();
#pragma unroll
        for (int ai = 0; ai < 2; ++ai)
#pragma unroll
            for (int m = 0; m < 4; ++m) { bf16_t* rowp = base + (size_t)(row0 + ai * HALF + m * 16) * 1024 + col0; const float r_ = rss[ai][m];
#pragma unroll
                for (int bj = 0; bj < 2; ++bj) { f32x4 v0 = acc[ai][bj][m][0] * r_, v1 = acc[ai][bj][m][1] * r_;
                    if (isg) {
#pragma unroll
                        for (int j = 0; j < 4; ++j) { v0[j] = gelu_tanh(v0[j]); v1[j] = gelu_tanh(v1[j]); } }
                    u32x4 w; w.x = cvt_pk_bf16(v0[0], v0[1]); w.y = cvt_pk_bf16(v0[2], v0[3]); w.z = cvt_pk_bf16(v1[0], v1[1]); w.w = cvt_pk_bf16(v1[2], v1[3]);
                    *(u32x4*)(rowp + bj * HALF) = w; } }
    }
};
struct EpiGate {
    static constexpr bool PERM = true;
    bf16_t* LA; bf16_t* IX; const bf16_t* XC; const float* lruc;
    __device__ __forceinline__ void operator()(AccRef acc, const Unit& u, int wr, int wc, int fr, int fq) const {
        const int row0 = u.pm * BM + wr * 64 + fr, ch0 = u.pn * HALF + wc * 32 + 8 * fq;
        u32x2 xws[2][2][4];
#pragma unroll
        for (int n = 0; n < 2; ++n)
#pragma unroll
            for (int ai = 0; ai < 2; ++ai)
#pragma unroll
                for (int m = 0; m < 4; ++m) xws[n][ai][m] = *(const u32x2*)(XC + (size_t)(row0 + ai * HALF + m * 16) * 1024 + ch0 + 4 * n);
        f32x4 bas[2], bxs[2], sps[2];
#pragma unroll
        for (int n = 0; n < 2; ++n) { bas[n] = *(const f32x4*)(lruc + ch0 + 4 * n); bxs[n] = *(const f32x4*)(lruc + 1024 + ch0 + 4 * n); sps[n] = *(const f32x4*)(lruc + 2048 + ch0 + 4 * n); }
        FENCE();
#pragma unroll
        for (int n = 0; n < 2; ++n) {
            const f32x4 ba = bas[n], bx = bxs[n], sp = sps[n];
#pragma unroll
            for (int ai = 0; ai < 2; ++ai)
#pragma unroll
                for (int m = 0; m < 4; ++m) { const size_t ro = (size_t)(row0 + ai * HALF + m * 16) * 1024 + ch0 + 4 * n;
                    const u32x2 xw = xws[n][ai][m];
                    const float xc[4] = {lo_bf(xw.x), hi_bf(xw.x), lo_bf(xw.y), hi_bf(xw.y)};
                    float la[4], ix[4];
#pragma unroll
                    for (int j = 0; j < 4; ++j) { const float r = sigmoidf_(acc[ai][0][m][n][j] + ba[j]), ii = sigmoidf_(acc[ai][1][m][n][j] + bx[j]); la[j] = -sp[j] * r; ix[j] = ii * xc[j]; }
                    u32x2 w; w.x = cvt_pk_bf16(la[0], la[1]); w.y = cvt_pk_bf16(la[2], la[3]); *(u32x2*)(LA + ro) = w;
                    w.x = cvt_pk_bf16(ix[0], ix[1]); w.y = cvt_pk_bf16(ix[2], ix[3]); *(u32x2*)(IX + ro) = w; }
        }
    }
};
struct EpiResX {
    static constexpr bool PERM = true;
    bf16_t* H; const float* x; const float* meta;
    __device__ __forceinline__ void operator()(AccRef acc, const Unit& u, int wr, int wc, int fr, int fq) const {
        const int row0 = u.pm * BM + wr * 64 + fr, col0 = u.pn * BM + wc * 32 + 8 * fq;
#pragma unroll
        for (int ai = 0; ai < 2; ++ai) {
            f32x4 xs[4][2][2];
            FENCE();
#pragma unroll
            for (int m = 0; m < 4; ++m) { const int row = row0 + ai * HALF + m * 16; const int b = row / LTOK, l = row - b * LTOK;
                const float* bp = (l < NMETA ? meta + (size_t)l * 1024 : x + ((size_t)b * SEQ + (l - NMETA)) * 1024) + col0;
#pragma unroll
                for (int bj = 0; bj < 2; ++bj) { xs[m][bj][0] = *(const f32x4*)(bp + bj * HALF); xs[m][bj][1] = *(const f32x4*)(bp + bj * HALF + 4); } }
            FENCE();
#pragma unroll
            for (int m = 0; m < 4; ++m) { const int row = row0 + ai * HALF + m * 16; bf16_t* rowp = H + (size_t)row * 1024 + col0;
#pragma unroll
                for (int bj = 0; bj < 2; ++bj) { const f32x4 v0 = acc[ai][bj][m][0] + xs[m][bj][0], v1 = acc[ai][bj][m][1] + xs[m][bj][1];
                    u32x4 w; w.x = cvt_pk_bf16(v0[0], v0[1]); w.y = cvt_pk_bf16(v0[2], v0[3]); w.z = cvt_pk_bf16(v1[0], v1[1]); w.w = cvt_pk_bf16(v1[2], v1[3]);
                    *(u32x4*)(rowp + bj * HALF) = w; } } }
    }
};
struct EpiResB {
    static constexpr bool PERM = true;
    bf16_t* H; const bf16_t* B; float sc;
    __device__ __forceinline__ void operator()(AccRef acc, const Unit& u, int wr, int wc, int fr, int fq) const {
        const int row0 = u.pm * BM + wr * 64 + fr, col0 = u.pn * BM + wc * 32 + 8 * fq;
        u32x4 hws[2][4][2];
#pragma unroll
        for (int ai = 0; ai < 2; ++ai)
#pragma unroll
            for (int m = 0; m < 4; ++m)
#pragma unroll
                for (int bj = 0; bj < 2; ++bj) hws[ai][m][bj] = *(const u32x4*)(B + (size_t)(row0 + ai * HALF + m * 16) * 1024 + col0 + bj * HALF);
        FENCE();
#pragma unroll
        for (int ai = 0; ai < 2; ++ai)
#pragma unroll
            for (int m = 0; m < 4; ++m) { const size_t ro = (size_t)(row0 + ai * HALF + m * 16) * 1024 + col0;
#pragma unroll
                for (int bj = 0; bj < 2; ++bj) { const u32x4 hw = hws[ai][m][bj];
                    const f32x4 v0 = acc[ai][bj][m][0] * sc + (f32x4){lo_bf(hw.x), hi_bf(hw.x), lo_bf(hw.y), hi_bf(hw.y)}, v1 = acc[ai][bj][m][1] * sc + (f32x4){lo_bf(hw.z), hi_bf(hw.z), lo_bf(hw.w), hi_bf(hw.w)};
                    u32x4 w; w.x = cvt_pk_bf16(v0[0], v0[1]); w.y = cvt_pk_bf16(v0[2], v0[3]); w.z = cvt_pk_bf16(v1[0], v1[1]); w.w = cvt_pk_bf16(v1[2], v1[3]);
                    *(u32x4*)(H + ro + bj * HALF) = w; } }
    }
};
}

struct Args { const float* in[25]; float* out; unsigned char* ws; int ph_lo, ph_hi, dry, pad; };
constexpr int LDS_BYTES = 155648;
constexpr int MISC_OFF = 155648 - 256;
constexpr int NPHASE = 16;

struct Frame {
    LAS unsigned char* lds; int tid, lane, wave, G, bid;
    const float* const* in; float* out; unsigned char* ws; unsigned* ctl; int dry;
};
#define WSP(T_, off) ((T_*)(F.ws + (off)))
#define DOP(T_, off) ((T_*)((unsigned char*)F.out + (off)))

__device__ __forceinline__ const float* h0_row(const Frame& F, int t) { const int b = t / LTOK, l = t - b * LTOK; return l < NMETA ? F.in[2] + (size_t)l * 1024 : F.in[0] + ((size_t)b * SEQ + (l - NMETA)) * 1024; }

template <class FN>
__device__ __forceinline__ void tr_w(bf16_t* dst, int nrows, int K, FN colp, int ld, int gtid, int gsz, float scale = 1.0f, const float* kscale = nullptr, int nvalid = 1 << 30) {
    const int items = nrows * (K / 8);
    float vn[8], ksn[8];
    auto ld8 = [&](int idx) { const int n = idx % nrows, k8 = idx / nrows; const float* p = colp(n);
#pragma unroll
        for (int j = 0; j < 8; ++j) { vn[j] = p[(size_t)(k8 * 8 + j) * ld]; ksn[j] = kscale ? kscale[k8 * 8 + j] : scale; } };
    if (gtid < items) ld8(gtid);
    for (int idx = gtid; idx < items; idx += gsz) { const int n = idx % nrows, k8 = idx / nrows;
        float v[8];
#pragma unroll
        for (int j = 0; j < 8; ++j) v[j] = vn[j];
        float ks[8];
#pragma unroll
        for (int j = 0; j < 8; ++j) ks[j] = ksn[j];
        if (idx + gsz < items) ld8(idx + gsz);
        const float live = n < nvalid ? 1.0f : 0.0f;
#pragma unroll
        for (int j = 0; j < 8; ++j) v[j] = v[j] * ks[j] * live;
        u32x4 w; w.x = cvt_pk_bf16(v[0], v[1]); w.y = cvt_pk_bf16(v[2], v[3]); w.z = cvt_pk_bf16(v[4], v[5]); w.w = cvt_pk_bf16(v[6], v[7]);
        *(u32x4*)(dst + (size_t)n * K + k8 * 8) = w; }
}
__device__ __forceinline__ int rope_src(int j) { return (j & 1) ? 32 + (j >> 1) : (j >> 1); }

__device__ __forceinline__ void norm_row_wave(const float* src, const float* g, bf16_t* dst, int lane) {
    f32x4 v[4]; float ss = 0.f;
#pragma unroll
    for (int j = 0; j < 4; ++j) { v[j] = *(const f32x4*)(src + j * 256 + lane * 4); ss += v[j][0] * v[j][0] + v[j][1] * v[j][1] + v[j][2] * v[j][2] + v[j][3] * v[j][3]; }
    ss = wave_sum(ss);
    const float rs = rsqrtf(ss * (1.0f / 1024.0f) + 1e-6f);
#pragma unroll
    for (int j = 0; j < 4; ++j) { const f32x4 gg = *(const f32x4*)(g + j * 256 + lane * 4);
        u32x2 w; w.x = cvt_pk_bf16(v[j][0] * rs * gg[0], v[j][1] * rs * gg[1]); w.y = cvt_pk_bf16(v[j][2] * rs * gg[2], v[j][3] * rs * gg[3]);
        *(u32x2*)(dst + j * 256 + lane * 4) = w; }
}

constexpr int TMAIN = 32768, TREM = T - TMAIN;
template <int KB, class AC, class FN>
__device__ __forceinline__ void mini_gemm(const Frame& F, const bf16_t* A, int lda, const bf16_t* Bt, int ldb, int K, int mt, int nt, AC acol, FN fn) {
    PLACE(PAD_M);
    const int l15 = F.lane & 15, kq = F.lane >> 4;
    for (int task = F.bid * NWAVES + F.wave; task < mt * nt; task += F.G * NWAVES) {
        const int rt = task % mt, ct = task / mt;
        const bf16_t* ap = A + (size_t)(rt * 16 + l15) * lda + acol(ct) + 8 * kq;
        const bf16_t* bp = Bt + (size_t)(ct * 16 + l15) * ldb + 8 * kq;
        f32x4 acc = (f32x4){0.f, 0.f, 0.f, 0.f};
        for (int k0 = 0; k0 < K; k0 += KB) {
            bf16x8 a[KB / 32], b[KB / 32];
#pragma unroll
            for (int s = 0; s < KB / 32; ++s) { a[s] = *(const bf16x8*)(ap + k0 + 32 * s); b[s] = *(const bf16x8*)(bp + k0 + 32 * s); }
#pragma unroll
            for (int s = 0; s < KB / 32; ++s) acc = __builtin_amdgcn_mfma_f32_16x16x32_bf16(a[s], b[s], acc, 0, 0, 0);
        }
        fn(rt, ct, acc);
    }
}
template <class AC, class FN>
__device__ __forceinline__ void coop_gemm(const Frame& F, const bf16_t* A, int lda, const bf16_t* Bt, int ldb, int K, int mt, int nt, AC acol, FN fn) {
    PLACE(PAD_M);
    constexpr int KC = 128, PITCH = KC * 2 + 16, BUF = 2 * 64 * PITCH;
    LAS unsigned char* lds = F.lds;
    const int tid = F.tid, lane = F.lane, w = F.wave, l15 = lane & 15, kq = lane >> 4;
    const int wr = w & 3, wc2 = (w >> 2) * 2;
    const int nbr = mt / 4, nbt = nbr * (nt / 4), nc = K / KC;
    const int sr = tid >> 3, sc = tid & 7;
    __syncthreads();
    for (int bt = F.bid; bt < nbt; bt += F.G) {
        const int br = bt % nbr, bc = bt / nbr;
        const bf16_t* ap = A + (size_t)(br * 64 + sr) * lda + acol(bc * 4) + sc * 8;
        const bf16_t* bp = Bt + (size_t)(bc * 64 + sr) * ldb + sc * 8;
        u32x4 ra0 = *(const u32x4*)ap, ra1 = *(const u32x4*)(ap + 64), rb0 = *(const u32x4*)bp, rb1 = *(const u32x4*)(bp + 64);
        f32x4 acc0 = (f32x4){0.f, 0.f, 0.f, 0.f}, acc1 = acc0;
        for (int c = 0; c < nc; ++c) {
            LAS unsigned char* sa = lds + (c & 1) * BUF; LAS unsigned char* sb = sa + 64 * PITCH;
            *(LAS u32x4*)(sa + sr * PITCH + sc * 16) = ra0; *(LAS u32x4*)(sa + sr * PITCH + (sc + 8) * 16) = ra1;
            *(LAS u32x4*)(sb + sr * PITCH + sc * 16) = rb0; *(LAS u32x4*)(sb + sr * PITCH + (sc + 8) * 16) = rb1;
            __syncthreads();
            if (c + 1 < nc) { const bf16_t* an = ap + (c + 1) * KC; const bf16_t* bn = bp + (c + 1) * KC;
                ra0 = *(const u32x4*)an; ra1 = *(const u32x4*)(an + 64); rb0 = *(const u32x4*)bn; rb1 = *(const u32x4*)(bn + 64); }
            const LAS unsigned char* fa = sa + (wr * 16 + l15) * PITCH + kq * 16; const LAS unsigned char* fb = sb + (wc2 * 16 + l15) * PITCH + kq * 16;
#pragma unroll
            for (int s4 = 0; s4 < 4; ++s4) { const bf16x8 a = *(const LAS bf16x8*)(fa + 64 * s4), b0 = *(const LAS bf16x8*)(fb + 64 * s4), b1 = *(const LAS bf16x8*)(fb + 16 * PITCH + 64 * s4);
                acc0 = __builtin_amdgcn_mfma_f32_16x16x32_bf16(a, b0, acc0, 0, 0, 0); acc1 = __builtin_amdgcn_mfma_f32_16x16x32_bf16(a, b1, acc1, 0, 0, 0); }
        }
        fn(br * 4 + wr, bc * 4 + wc2, acc0); fn(br * 4 + wr, bc * 4 + wc2 + 1, acc1);
        __syncthreads();
    }
}
__device__ __forceinline__ unsigned short f2bf(float f) { return (unsigned short)(cvt_pk_bf16(f, 0.f) & 0xffffu); }

constexpr int P1_UNITS = (T / 256) * 3;
__device__ __forceinline__ void conv_tables(const Frame& F, int r_lo, int r_hi, int widx, int wcount) {
    const float* const* in = F.in;
      static_assert(U_FP4 && V_FP4, "fp4 tables");
      unsigned char* uvd = WSP(unsigned char, WS_U); float* us = WSP(float, WS_USC); float* vs = WSP(float, WS_VSC);
      LAS unsigned char* scr = F.lds + F.wave * 8192; const int lane = F.lane;
      f32x4 tu[4], tv[4];
      const int rstep = wcount * NWAVES; int r = r_lo + widx * NWAVES + F.wave;
      if (r < r_hi) { const float* su = in[23] + (size_t)r * 1024; const float* sv = in[24] + (size_t)r * 1024;
#pragma unroll
          for (int j = 0; j < 4; ++j) { tu[j] = __builtin_nontemporal_load((const f32x4*)(su + (j * 64 + lane) * 4)); tv[j] = __builtin_nontemporal_load((const f32x4*)(sv + (j * 64 + lane) * 4)); } }
      for (; r < r_hi; r += rstep) {
#pragma unroll
          for (int j = 0; j < 4; ++j) { *(LAS f32x4*)(scr + (j * 64 + lane) * 16) = tu[j]; *(LAS f32x4*)(scr + 4096 + (j * 64 + lane) * 16) = tv[j]; }
          asm volatile("s_waitcnt lgkmcnt(0)" ::: "memory");
          if (r + rstep < r_hi) { const float* su = in[23] + (size_t)(r + rstep) * 1024; const float* sv = in[24] + (size_t)(r + rstep) * 1024;
#pragma unroll
              for (int j = 0; j < 4; ++j) { tu[j] = __builtin_nontemporal_load((const f32x4*)(su + (j * 64 + lane) * 4)); tv[j] = __builtin_nontemporal_load((const f32x4*)(sv + (j * 64 + lane) * 4)); } }
          f32x4 v[2][4]; float am[2] = {0.f, 0.f};
#pragma unroll
          for (int tb = 0; tb < 2; ++tb)
#pragma unroll
              for (int j = 0; j < 4; ++j) { v[tb][j] = *(const LAS f32x4*)(scr + tb * 4096 + lane * 64 + j * 16); am[tb] = fmaxf(am[tb], fmaxf(fmaxf(fabsf(v[tb][j][0]), fabsf(v[tb][j][1])), fmaxf(fabsf(v[tb][j][2]), fabsf(v[tb][j][3])))); }
          asm volatile("s_waitcnt lgkmcnt(0)" ::: "memory");
          u32x4 w;
#pragma unroll
          for (int tb = 0; tb < 2; ++tb) { float a = am[tb];
#pragma unroll
              for (int o = 32; o >= 1; o >>= 1) a = fmaxf(a, __shfl_xor(a, o));
              const float sc = a > 0.f ? 6.0f / a : 1.0f, inv = a > 0.f ? a / 6.0f : 1.0f;
              unsigned p = 0u, q = 0u;
              p = __builtin_amdgcn_cvt_scalef32_pk_fp4_f32(p, v[tb][0][0] * sc, v[tb][0][1] * sc, 1.0f, 0); p = __builtin_amdgcn_cvt_scalef32_pk_fp4_f32(p, v[tb][0][2] * sc, v[tb][0][3] * sc, 1.0f, 1);
              p = __builtin_amdgcn_cvt_scalef32_pk_fp4_f32(p, v[tb][1][0] * sc, v[tb][1][1] * sc, 1.0f, 2); p = __builtin_amdgcn_cvt_scalef32_pk_fp4_f32(p, v[tb][1][2] * sc, v[tb][1][3] * sc, 1.0f, 3);
              q = __builtin_amdgcn_cvt_scalef32_pk_fp4_f32(q, v[tb][2][0] * sc, v[tb][2][1] * sc, 1.0f, 0); q = __builtin_amdgcn_cvt_scalef32_pk_fp4_f32(q, v[tb][2][2] * sc, v[tb][2][3] * sc, 1.0f, 1);
              q = __builtin_amdgcn_cvt_scalef32_pk_fp4_f32(q, v[tb][3][0] * sc, v[tb][3][1] * sc, 1.0f, 2); q = __builtin_amdgcn_cvt_scalef32_pk_fp4_f32(q, v[tb][3][2] * sc, v[tb][3][3] * sc, 1.0f, 3);
              if (tb == 0) { w.x = p; w.y = q; } else { w.z = p; w.w = q; }
              if (lane == 0) (tb ? vs : us)[r] = inv; }
          *(u32x4*)(uvd + (size_t)r * 1024 + lane * 16) = w; } }

__device__ __forceinline__ void p0_prologue(const Frame& F) {
    PLACE(PAD_S);
    const int gtid = F.bid * NTHREADS + F.tid, gsz = F.G * NTHREADS;
    const float* const* in = F.in;
    { const float* w = in[6];
      tr_w(WSP(bf16_t, WS_WIN0), 768, 1024, [=](int n) -> const float* { if (n >= 704) return w; if (n < 640) return w + n; return w + 640 + rope_src(n - 640); }, 704, gtid, gsz, 1.0f, nullptr, 704); }
    { const float* w = in[8];
      tr_w(WSP(bf16_t, WS_WQUP), 1536, 384, [=](int n) -> const float* { const int h = n / 192, d = n % 192; return w + h * 192 + (d < 128 ? d : 128 + rope_src(d - 128)); }, 1536, gtid, gsz, QSCALE); }
    { const float* w = in[10];
      tr_w(WSP(bf16_t, WS_WK), 1024, 256, [=](int n) -> const float* { return w + (n >> 7) * 256 + (n & 127); }, 2048, gtid, gsz);
      tr_w(WSP(bf16_t, WS_WV), 1024, 256, [=](int n) -> const float* { return w + (n >> 7) * 256 + 128 + (n & 127); }, 2048, gtid, gsz); }
    { const float* w = in[11]; tr_w(WSP(bf16_t, WS_WOUT0), 1024, 1024, [=](int n) -> const float* { return w + n; }, 1024, gtid, gsz); }
    { const float* w = in[12]; tr_w(WSP(bf16_t, WS_WLIN), 2048, 1024, [=](int n) -> const float* { return w + n; }, 2048, gtid, gsz, 1.0f, in[3] + 1024); }
    { const float* w = in[20]; tr_w(WSP(bf16_t, WS_WLOUT), 1024, 1024, [=](int n) -> const float* { return w + n; }, 1024, gtid, gsz); }
    {
      const float* wa = in[15]; const float* wx = in[17]; bf16_t* dst = WSP(bf16_t, WS_WGATE);
      const int items = 2048 * 32;
      for (int idx = gtid; idx < items; idx += gsz) { const int n = idx % 2048, k8 = idx / 2048; const int j = n >> 8, e = n & 127; const bool isx = (n & 128) != 0;
          const float* src = (isx ? wx : wa) + (size_t)j * 128 * 128 + e; const int klo = 128 * (j & 1);
          float v[8];
#pragma unroll
          for (int q = 0; q < 8; ++q) { const int k = k8 * 8 + q - klo; v[q] = (k >= 0 && k < 128) ? src[(size_t)k * 128] : 0.f; }
          u32x4 w; w.x = cvt_pk_bf16(v[0], v[1]); w.y = cvt_pk_bf16(v[2], v[3]); w.z = cvt_pk_bf16(v[4], v[5]); w.w = cvt_pk_bf16(v[6], v[7]);
          *(u32x4*)(dst + (size_t)n * 256 + k8 * 8) = w; } }
    for (int l = 0; l < 2; ++l) { const float* w = in[21] + (size_t)l * 1024 * 2048; tr_w(WSP(bf16_t, WS_WPQ) + (size_t)l * 2048 * 1024, 2048, 1024, [=](int n) -> const float* { return w + n; }, 2048, gtid, gsz, 1.0f, in[4] + l * 1024); }
    { const float* s = in[22]; bf16_t* d = WSP(bf16_t, WS_KEYS); for (int i = gtid; i < 2 * 2 * 128 * 128 / 8; i += gsz) { const f32x4 a = *(const f32x4*)(s + (size_t)i * 8), b = *(const f32x4*)(s + (size_t)i * 8 + 4);
        u32x4 w; w.x = cvt_pk_bf16(a[0], a[1]); w.y = cvt_pk_bf16(a[2], a[3]); w.z = cvt_pk_bf16(b[0], b[1]); w.w = cvt_pk_bf16(b[2], b[3]); *(u32x4*)(d + (size_t)i * 8) = w; } }
    { const int n2 = P1_UNITS - F.G; const bool split = n2 > 0 && n2 + 32 < F.G;
      conv_tables(F, 0, split ? 16384 : 2 * 16384, F.bid, F.G); }
    for (int c = gtid; c < 1024; c += gsz) { float* d = WSP(float, WS_LRUC); d[c] = in[16][c]; d[1024 + c] = in[18][c]; const float nl = -in[19][c];
        d[2048 + c] = 8.0f * (nl > 20.f ? nl : log1pf(expf(nl))); }
    { float* d = WSP(float, WS_ROPE); const int* pos = (const int*)in[1];
      for (int idx = gtid; idx < T * 32; idx += gsz) { const int t = idx >> 5, i = idx & 31; const int b = t / LTOK, l = t - b * LTOK;
          const int p = l < NMETA ? l : pos[b * SEQ + (l - NMETA)] + NMETA;
          const float fr = powf(10000.0f, -(float)i / 32.0f); const float ang = (float)p * fr; float sn, cs; sincosf(ang, &sn, &cs);
          d[(size_t)idx * 2] = cs; d[(size_t)idx * 2 + 1] = sn; } }
    { bf16_t* hn = WSP(bf16_t, WS_RA); const int lane = F.lane, tstep = F.G * NWAVES;
      f32x4 gg[4], vn[4];
#pragma unroll
      for (int j = 0; j < 4; ++j) gg[j] = *(const f32x4*)(in[3] + j * 256 + lane * 4);
      int t = F.bid * NWAVES + F.wave;
      if (t < T) { const float* src = h0_row(F, t);
#pragma unroll
          for (int j = 0; j < 4; ++j) vn[j] = *(const f32x4*)(src + j * 256 + lane * 4); }
      for (; t < T; t += tstep) {
          f32x4 v[4]; float ss = 0.f;
#pragma unroll
          for (int j = 0; j < 4; ++j) { v[j] = vn[j]; ss += v[j][0] * v[j][0] + v[j][1] * v[j][1] + v[j][2] * v[j][2] + v[j][3] * v[j][3]; }
          if (t + tstep < T) { const float* src = h0_row(F, t + tstep);
#pragma unroll
              for (int j = 0; j < 4; ++j) vn[j] = *(const f32x4*)(src + j * 256 + lane * 4); }
          ss = wave_sum(ss);
          const float rs = rsqrtf(ss * (1.0f / 1024.0f) + 1e-6f);
          bf16_t* dst = hn + (size_t)t * 1024;
#pragma unroll
          for (int j = 0; j < 4; ++j) { u32x2 w; w.x = cvt_pk_bf16(v[j][0] * rs * gg[j][0], v[j][1] * rs * gg[j][1]); w.y = cvt_pk_bf16(v[j][2] * rs * gg[j][2], v[j][3] * rs * gg[j][3]);
              *(u32x2*)(dst + j * 256 + lane * 4) = w; } } }
}

__device__ __forceinline__ void norm_phase(const Frame& F, const float* g) {
    const float* h = WSP(float, WS_H); bf16_t* hn = WSP(bf16_t, WS_RA);
    for (int t = F.bid * NWAVES + F.wave; t < T; t += F.G * NWAVES) norm_row_wave(h + (size_t)t * 1024, g, hn + (size_t)t * 1024, F.lane);
}

__device__ __forceinline__ void latnorm_phase(const Frame& F) {
    PLACE(PAD_S);
    const bf16_t* a = WSP(bf16_t, WS_RB); bf16_t* qn = DOP(bf16_t, DO_QN); bf16_t* kvn = DOP(bf16_t, DO_KVN); bf16_t* kpe = DOP(bf16_t, DO_KPE);
    const float* gq = F.in[7]; const float* gkv = F.in[9]; const float* rope = WSP(float, WS_ROPE);
    const int lane = F.lane;
    float gg[2][8];
#pragma unroll
    for (int j = 0; j < 2; ++j) { const int c = lane + 64 * j;
#pragma unroll
        for (int q = 0; q < 8; ++q) gg[j][q] = c < 48 ? gq[c * 8 + q] : c < 80 ? gkv[(c - 48) * 8 + q] : 0.f; }
    const bool rl = lane + 64 >= 80 && lane + 64 < 88;
    const int i0 = rl ? (lane + 64 - 80) * 4 : 0;
    u32x4 wn[2]; f32x4 rn[2];
    auto ldrow = [&](int t) { const bf16_t* row = a + (size_t)t * 768;
#pragma unroll
        for (int j = 0; j < 2; ++j) { const int c = lane + 64 * j; wn[j] = c < 88 ? *(const u32x4*)(row + c * 8) : (u32x4){0u, 0u, 0u, 0u}; }
        const float* rp = rope + ((size_t)t * 32 + i0) * 2; rn[0] = rl ? *(const f32x4*)rp : (f32x4){0.f, 0.f, 0.f, 0.f}; rn[1] = rl ? *(const f32x4*)(rp + 4) : (f32x4){0.f, 0.f, 0.f, 0.f}; };
    const int tstep = F.G * NWAVES;
    int t = F.bid * NWAVES + F.wave;
    if (t < T) ldrow(t);
    for (; t < T; t += tstep) {
        const u32x4 wc2[2] = {wn[0], wn[1]}; const f32x4 r0 = rn[0], r1 = rn[1];
        if (t + tstep < T) ldrow(t + tstep);
        float v[2][8]; float sq = 0.f, skv = 0.f;
#pragma unroll
        for (int j = 0; j < 2; ++j) { const int c = lane + 64 * j; const u32x4 w = wc2[j];
            v[j][0] = lo_bf(w.x); v[j][1] = hi_bf(w.x); v[j][2] = lo_bf(w.y); v[j][3] = hi_bf(w.y); v[j][4] = lo_bf(w.z); v[j][5] = hi_bf(w.z); v[j][6] = lo_bf(w.w); v[j][7] = hi_bf(w.w);
            float s_ = 0.f;
#pragma unroll
            for (int q = 0; q < 8; ++q) s_ += v[j][q] * v[j][q];
            if (c < 48) sq += s_; else if (c < 80) skv += s_; }
        sq = wave_sum(sq); skv = wave_sum(skv);
        const float rq = rsqrtf(sq * (1.0f / 384.0f) + 1e-6f), rkv = rsqrtf(skv * (1.0f / 256.0f) + 1e-6f);
#pragma unroll
        for (int j = 0; j < 2; ++j) { const int c = lane + 64 * j; float o[8];
            const float rr = c < 48 ? rq : rkv;
#pragma unroll
            for (int q = 0; q < 8; ++q) o[q] = v[j][q] * rr * gg[j][q];
            if (j == 1 && rl) { const float cs[4] = {r0[0], r0[2], r1[0], r1[2]}, sn[4] = {r0[1], r0[3], r1[1], r1[3]};
#pragma unroll
                for (int p = 0; p < 4; ++p) { o[2 * p] = v[j][2 * p] * cs[p] - v[j][2 * p + 1] * sn[p]; o[2 * p + 1] = v[j][2 * p + 1] * cs[p] + v[j][2 * p] * sn[p]; } }
            u32x4 w; w.x = cvt_pk_bf16(o[0], o[1]); w.y = cvt_pk_bf16(o[2], o[3]); w.z = cvt_pk_bf16(o[4], o[5]); w.w = cvt_pk_bf16(o[6], o[7]);
            if (c < 48) *(u32x4*)(qn + (size_t)t * 384 + c * 8) = w;
            else if (c < 80) *(u32x4*)(kvn + (size_t)t * 256 + (c - 48) * 8) = w;
            else if (c < 88) *(u32x4*)(kpe + (size_t)t * 64 + (c - 80) * 8) = w; }
    }
}

#ifndef AT_KG
#define AT_KG 6
#endif
constexpr int AT_KB = 64 * 384, AT_VB = 128 * 128;
constexpr int AT_K0 = 0, AT_V0 = 2 * AT_KB, AT_LDS = 2 * AT_KB + 2 * AT_VB;
static_assert(AT_LDS <= MISC_OFF, "attention LDS");
__device__ __forceinline__ void attn_phase(const Frame& F) {
    PLACE(PAD_A);
    const bf16_t* Q = WSP(bf16_t, WS_H); bf16_t* O = WSP(bf16_t, WS_RA); const float* rope = WSP(float, WS_ROPE);
    const __amdgpu_buffer_rsrc_t krs = __builtin_amdgcn_make_buffer_rsrc((void*)F.out, 0, BATCH * SEQ * D * 4, 0x00020000);
    const __amdgpu_buffer_rsrc_t vrs = __builtin_amdgcn_make_buffer_rsrc((void*)(F.ws + WS_RB + U1), 0, (int)U1, 0x00020000);
    LAS unsigned char* lds = F.lds; volatile LAS int* misc = (volatile LAS int*)(F.lds + MISC_OFF);
    const int tid = F.tid, w = F.wave;
    const int qt_order[9] = {7, 6, 5, 4, 3, 2, 1, 0, 8};
    for (;;) {
        __syncthreads();
        if (tid == 0) misc[16] = (int)atomicAdd(F.ctl + CW_ATTN + 64 * F.dry, 1u);
        __syncthreads();
        const int u = misc[16];
        if (u >= 9 * 128) break;
        int qt = 0;
#pragma unroll
        for (int i = 0; i < 9; ++i) if (u / 128 == i) qt = qt_order[i];
        const int bh = u & 127, b = bh >> 3, h = bh & 7;
        int lane = F.lane; asm volatile("" : "+v"(lane));
        const int q = lane & 31, hf = lane >> 5;
        const int rb = qt < 8 ? 16 + 256 * qt : 0, rlim = qt < 8 ? LTOK : 16;
        const int rowq = rb + 32 * w + q, rowc = rowq < rlim ? rowq : rlim - 1;
        const size_t tq = (size_t)b * LTOK + rowc;
        bf16x8 qf[12];
#pragma unroll
        for (int s = 0; s < 12; ++s) qf[s] = *(const bf16x8*)(Q + tq * 1536 + h * 192 + 16 * s + 8 * hf);
#pragma unroll
        for (int s = 8; s < 12; ++s) {
            const float* rp = rope + (tq * 32 + 8 * (s - 8) + 4 * hf) * 2; const f32x4 c0 = *(const f32x4*)rp, c1 = *(const f32x4*)(rp + 4);
            const u32x4 qw = __builtin_bit_cast(u32x4, qf[s]);
            const float x0 = lo_bf(qw.x), y0 = hi_bf(qw.x), x1 = lo_bf(qw.y), y1 = hi_bf(qw.y), x2 = lo_bf(qw.z), y2 = hi_bf(qw.z), x3 = lo_bf(qw.w), y3 = hi_bf(qw.w);
            u32x4 ow; ow.x = cvt_pk_bf16(x0 * c0[0] - y0 * c0[1], y0 * c0[0] + x0 * c0[1]); ow.y = cvt_pk_bf16(x1 * c0[2] - y1 * c0[3], y1 * c0[2] + x1 * c0[3]);
            ow.z = cvt_pk_bf16(x2 * c1[0] - y2 * c1[1], y2 * c1[0] + x2 * c1[1]); ow.w = cvt_pk_bf16(x3 * c1[2] - y3 * c1[3], y3 * c1[2] + x3 * c1[3]);
            qf[s] = __builtin_bit_cast(bf16x8, ow); }
        f32x16 oacc[4];
#pragma unroll
        for (int i = 0; i < 4; ++i)
#pragma unroll
            for (int r = 0; r < 16; ++r) oacc[i][r] = 0.f;
        float mrun = -1e30f, lrun = 0.f;
        const int wave_row_lo = rb + 32 * w;
        const bool wave_valid = wave_row_lo < rlim;
        const int wave_kmax = (wave_row_lo + 31 < rlim ? wave_row_lo + 31 : rlim - 1);
        const int wg_kmax = (rb + 255 < rlim ? rb + 255 : rlim - 1);
        const int nkt = wg_kmax / 64 + 1;
        int kvo[3], kst[3], vvo[2];
#pragma unroll
        for (int i = 0; i < 3; ++i) { const int o = (w * 3 + i) * 1024 + lane * 16, rho = o / 384, cp = (o - rho * 384) >> 4, c = (cp & 24) | ((cp & 7) ^ ((rho >> 1) & 7));
            const int key = (rho & 0x33) | ((rho & 4) << 1) | ((rho & 8) >> 1), row = b * LTOK + key;
            kvo[i] = c < 16 ? (int)DO_KN + row * 2048 + h * 256 + c * 16 : (int)DO_KPE + row * 128 + (c - 16) * 16; kst[i] = c < 16 ? 64 * 2048 : 64 * 128; }
#pragma unroll
        for (int i = 0; i < 2; ++i) { const int o = (w * 2 + i) * 1024 + lane * 16, d = o >> 7, c = (lane & 7) ^ ((d >> 1) & 7);
            vvo[i] = ((h * 128 + d) * T + b * LTOK + c * 8) * 2; }
        auto issue_tile = [&](int kt, int nbuf) {
#pragma unroll
            for (int i = 0; i < 3; ++i) { __builtin_amdgcn_raw_ptr_buffer_load_lds(krs, (LAS void*)(lds + AT_K0 + nbuf * AT_KB + (w * 3 + i) * 1024), 16, kvo[i], 0, 0, 0); kvo[i] += kst[i]; }
#pragma unroll
            for (int i = 0; i < 2; ++i) __builtin_amdgcn_raw_ptr_buffer_load_lds(vrs, (LAS void*)(lds + AT_V0 + nbuf * AT_VB + (w * 2 + i) * 1024), 16, vvo[i], kt * 128, 0, 0);
        };
        int kro[4], vro[4];
        { const int x = (q >> 1) & 7;
#pragma unroll
          for (int j = 0; j < 4; ++j) { kro[j] = q * 384 + (((2 * j + hf) ^ x) << 4); vro[j] = q * 128 + (((2 * j + hf) ^ x) << 4); } }
        issue_tile(0, 0);
        for (int kt = 0; kt < nkt; ++kt) {
            const int buf = kt & 1;
            asm volatile("s_waitcnt vmcnt(0)" ::: "memory");
            __syncthreads();
            if (kt + 1 < nkt) issue_tile(kt + 1, buf ^ 1);
            if (wave_valid && kt * 64 <= wave_kmax) {
                const LAS unsigned char* kb_ = lds + AT_K0 + buf * AT_KB; const LAS unsigned char* vb_ = lds + AT_V0 + buf * AT_VB;
                f32x16 sacc[2];
#pragma unroll
                for (int kb = 0; kb < 2; ++kb)
#pragma unroll
                    for (int r = 0; r < 16; ++r) sacc[kb][r] = 0.f;
                {
                    constexpr int KG = AT_KG, NG = 24 / KG;
                    bf16x8 kf[2][KG];
#define AT_KLD(g_) _Pragma("unroll") for (int i_ = 0; i_ < KG; ++i_) { const int s_ = ((g_) * KG + i_) % 12, kbb_ = ((g_) * KG + i_) / 12; kf[(g_) & 1][i_] = *(const LAS bf16x8*)(kb_ + kro[s_ & 3] + kbb_ * 32 * 384 + (s_ >> 2) * 128); }
                    AT_KLD(0);
#pragma unroll
                    for (int g = 0; g < NG; ++g) {
                        if (g + 1 < NG) { AT_KLD(g + 1); }
                        __builtin_amdgcn_sched_barrier(0);
#pragma unroll
                        for (int i = 0; i < KG; ++i) { const int s_ = (g * KG + i) % 12, kbb_ = (g * KG + i) / 12; sacc[kbb_] = __builtin_amdgcn_mfma_f32_32x32x16_bf16(kf[g & 1][i], qf[s_], sacc[kbb_], 0, 0, 0); }
                        __builtin_amdgcn_sched_barrier(0);
                    }
#undef AT_KLD
                }
                if (kt * 64 + 63 > wave_row_lo) {
                    asm volatile("" ::: "memory");
#pragma unroll
                    for (int kb = 0; kb < 2; ++kb)
#pragma unroll
                        for (int r = 0; r < 16; ++r) { const int key = kt * 64 + kb * 32 + (r & 3) + 4 * ((r >> 2) & 1) + 8 * hf + 16 * (r >> 3); if (key > rowq) sacc[kb][r] = -1e30f; }
                }
                float mx = -1e30f;
#pragma unroll
                for (int kb = 0; kb < 2; ++kb)
#pragma unroll
                    for (int r = 0; r < 16; ++r) mx = fmaxf(mx, sacc[kb][r]);
                mx = fmaxf(mx, __shfl_xor(mx, 32));
                if (__builtin_amdgcn_ballot_w64(mx > mrun + 8.0f) != 0ull) {
                    const float mnew = fmaxf(mrun, mx), alpha = fexp2(mrun - mnew);
                    lrun *= alpha; mrun = mnew;
#pragma unroll
                    for (int i = 0; i < 4; ++i)
#pragma unroll
                        for (int r = 0; r < 16; ++r) oacc[i][r] *= alpha;
                }
                float ls = 0.f;
#pragma unroll
                for (int kb = 0; kb < 2; ++kb)
#pragma unroll
                    for (int r = 0; r < 16; ++r) { const float p = fexp2(sacc[kb][r] - mrun); sacc[kb][r] = p; ls += p; }
                lrun += ls;
                bf16x8 pf[4];
#pragma unroll
                for (int kb = 0; kb < 2; ++kb)
#pragma unroll
                    for (int s2 = 0; s2 < 2; ++s2) { u32x4 pw; pw.x = cvt_pk_bf16(sacc[kb][8 * s2 + 0], sacc[kb][8 * s2 + 1]); pw.y = cvt_pk_bf16(sacc[kb][8 * s2 + 2], sacc[kb][8 * s2 + 3]);
                        pw.z = cvt_pk_bf16(sacc[kb][8 * s2 + 4], sacc[kb][8 * s2 + 5]); pw.w = cvt_pk_bf16(sacc[kb][8 * s2 + 6], sacc[kb][8 * s2 + 7]); pf[2 * kb + s2] = __builtin_bit_cast(bf16x8, pw); }
                {
                    bf16x8 vf[2][4];
#define AT_VLD(b_) _Pragma("unroll") for (int i_ = 0; i_ < 4; ++i_) vf[(b_) & 1][i_] = *(const LAS bf16x8*)(vb_ + vro[i_] + (b_) * 32 * 128)
                    AT_VLD(0);
#pragma unroll
                    for (int blk = 0; blk < 4; ++blk) {
                        if (blk + 1 < 4) { AT_VLD(blk + 1); }
                        __builtin_amdgcn_sched_barrier(0);
#pragma unroll
                        for (int i = 0; i < 4; ++i) oacc[blk] = __builtin_amdgcn_mfma_f32_32x32x16_bf16(vf[blk & 1][i], pf[i], oacc[blk], 0, 0, 0);
                        __builtin_amdgcn_sched_barrier(0);
                    }
#undef AT_VLD
                }
            }
        }
        const float ltot = lrun + __shfl_xor(lrun, 32), inv = 1.0f / ltot;
        if (rowq < rlim) {
            bf16_t* op = O + tq * 1024 + h * 128;
#pragma unroll
            for (int blk = 0; blk < 4; ++blk)
#pragma unroll
                for (int gp = 0; gp < 4; gp += 2) {
                    const unsigned ax = cvt_pk_bf16(oacc[blk][4 * gp + 0] * inv, oacc[blk][4 * gp + 1] * inv), ay = cvt_pk_bf16(oacc[blk][4 * gp + 2] * inv, oacc[blk][4 * gp + 3] * inv);
                    const unsigned bx = cvt_pk_bf16(oacc[blk][4 * gp + 4] * inv, oacc[blk][4 * gp + 5] * inv), by = cvt_pk_bf16(oacc[blk][4 * gp + 6] * inv, oacc[blk][4 * gp + 7] * inv);
                    const auto r0 = __builtin_amdgcn_permlane32_swap(ax, bx, false, false); const auto r1 = __builtin_amdgcn_permlane32_swap(ay, by, false, false);
                    *(u32x4*)(op + blk * 32 + 8 * (gp + hf)) = (u32x4){r0[0], r1[0], r0[1], r1[1]}; }
        }
    }
}

__device__ __forceinline__ unsigned f2key(float f) { const unsigned b = __float_as_uint(f); return b ^ ((unsigned)((int)b >> 31) | 0x80000000u); }
__device__ __forceinline__ float key2f(unsigned k) { const unsigned b = (k & 0x80000000u) ? (k ^ 0x80000000u) : ~k; return __uint_as_float(b); }
template <int N> __device__ __forceinline__ unsigned dpp_ror(unsigned x) { return (unsigned)__builtin_amdgcn_update_dpp(0, (int)x, 0x120 + N, 0xf, 0xf, false); }
__device__ __forceinline__ unsigned rowmax_u(unsigned x) { unsigned y;
    y = dpp_ror<8>(x); x = x > y ? x : y; y = dpp_ror<4>(x); x = x > y ? x : y; y = dpp_ror<2>(x); x = x > y ? x : y; y = dpp_ror<1>(x); x = x > y ? x : y; return x; }
__device__ __forceinline__ float rowsum_f(float x) {
    x += __uint_as_float(dpp_ror<8>(__float_as_uint(x))); x += __uint_as_float(dpp_ror<4>(__float_as_uint(x))); x += __uint_as_float(dpp_ror<2>(__float_as_uint(x))); x += __uint_as_float(dpp_ror<1>(__float_as_uint(x))); return x; }
#define CEX(a, b) do { const unsigned _mx = (a) > (b) ? (a) : (b), _mn = (a) > (b) ? (b) : (a); (a) = _mx; (b) = _mn; } while (0)

constexpr int PE_LE = 0;
constexpr int PE_LG = 8192;
constexpr int PE_RSTD = 16384;
constexpr int PE_KEYS = 16384 + 64;
constexpr int PE_KP = 272;
constexpr int PE_XS = PE_KEYS + 256 * PE_KP;
constexpr int PE_RSA = PE_XS + 8 * 1024;
constexpr int PE_COOP = (PE_RSA + 144 * 4 + 15) / 16 * 16;
constexpr int PE_SLE = PE_COOP + 8 * 4096, PE_SLG = PE_SLE + 1024;
constexpr int PE_CELL = PE_SLG + 1024;
static_assert(PE_XS % 16 == 0 && PE_CELL + 512 <= MISC_OFF, "peer LDS");

template <bool F4> __device__ __forceinline__ void dec16(const u32x4 a, f32x2 (&c)[8]) {
    if (F4) {
        c[0] = __builtin_amdgcn_cvt_scalef32_pk_f32_fp4(a.x, 1.0f, 0); c[1] = __builtin_amdgcn_cvt_scalef32_pk_f32_fp4(a.x, 1.0f, 1); c[2] = __builtin_amdgcn_cvt_scalef32_pk_f32_fp4(a.x, 1.0f, 2); c[3] = __builtin_amdgcn_cvt_scalef32_pk_f32_fp4(a.x, 1.0f, 3);
        c[4] = __builtin_amdgcn_cvt_scalef32_pk_f32_fp4(a.y, 1.0f, 0); c[5] = __builtin_amdgcn_cvt_scalef32_pk_f32_fp4(a.y, 1.0f, 1); c[6] = __builtin_amdgcn_cvt_scalef32_pk_f32_fp4(a.y, 1.0f, 2); c[7] = __builtin_amdgcn_cvt_scalef32_pk_f32_fp4(a.y, 1.0f, 3);
    } else {
        c[0] = __builtin_amdgcn_cvt_pk_f32_fp8((int)a.x, false); c[1] = __builtin_amdgcn_cvt_pk_f32_fp8((int)a.x, true); c[2] = __builtin_amdgcn_cvt_pk_f32_fp8((int)a.y, false); c[3] = __builtin_amdgcn_cvt_pk_f32_fp8((int)a.y, true);
        c[4] = __builtin_amdgcn_cvt_pk_f32_fp8((int)a.z, false); c[5] = __builtin_amdgcn_cvt_pk_f32_fp8((int)a.z, true); c[6] = __builtin_amdgcn_cvt_pk_f32_fp8((int)a.w, false); c[7] = __builtin_amdgcn_cvt_pk_f32_fp8((int)a.w, true);
    }
}
template <bool F4> __device__ __forceinline__ u32x4 ldrow(__amdgpu_buffer_rsrc_t rs, int e, int lane) {
    if (F4) { const u32x2 w = __builtin_bit_cast(u32x2, __builtin_amdgcn_raw_buffer_load_b64(rs, lane * 8, e * 512, 0)); return (u32x4){w.x, w.y, 0u, 0u}; }
    return __builtin_bit_cast(u32x4, __builtin_amdgcn_raw_buffer_load_b128(rs, lane * 16, e * 1024, 0));
}

template <bool FINAL>
__device__ __forceinline__ void peer_phase(const Frame& F, int layer) {
    PLACE(PAD_P);
    const bf16_t* pq = WSP(bf16_t, WS_RB); const bf16_t* hres = WSP(bf16_t, WS_H); bf16_t* hout = WSP(bf16_t, WS_H2); float* rs2 = WSP(float, WS_RS2);
    const float* gffn = F.in[4] + layer * 1024;
    const bf16_t* keys = WSP(bf16_t, WS_KEYS) + (size_t)layer * 2 * 128 * 128;
    const unsigned char* uvtab = WSP(unsigned char, WS_U) + (size_t)layer * 16384 * 1024;
    const float* usc = WSP(float, WS_USC) + layer * 16384; const float* vsc = WSP(float, WS_VSC) + layer * 16384;
    const __amdgpu_buffer_rsrc_t uvrsrc = __builtin_amdgcn_make_buffer_rsrc((void*)uvtab, 0, 16384 * 1024, 0x00020000);
    static_assert(U_FP4 && V_FP4, "the interleaved [u | v] row layout below is for fp4 tables");
    const float* gnext = F.in[5];
    LAS unsigned char* lds = F.lds;
    const int tid = F.tid, lane = F.lane, hh = F.wave;
    unsigned cellpk = 0u, cellvalid = 0u;
    { int c = 0; for (int i = 0; i < 16; ++i) for (int j = 0; j < 16 / (i + 1); ++j) { if ((c & 15) == (lane & 15)) { cellpk |= (unsigned)((i << 4) | j) << (8 * (c >> 4)); cellvalid |= 1u << (c >> 4); } ++c; } }
    if (hh == 0) { *(LAS unsigned*)(lds + PE_CELL + lane * 8) = cellpk; *(LAS unsigned*)(lds + PE_CELL + lane * 8 + 4) = cellvalid; }
    for (int c = tid; c < 256 * 16; c += NTHREADS) { const int r = c >> 4, cc = c & 15; *(LAS u32x4*)(lds + PE_KEYS + r * PE_KP + cc * 16) = *(const u32x4*)(keys + (size_t)r * 128 + cc * 8); }
    const int tpw = (T + F.G - 1) / F.G;
    const int tok_lo = F.bid * tpw < T ? F.bid * tpw : T, tok_hi = tok_lo + tpw < T ? tok_lo + tpw : T;
    if (tid == 0) *(LAS int*)(lds + MISC_OFF + 80) = 0;
    for (int tb = tok_lo + hh; tb < tok_hi; tb += 32) {
        u32x4 r0[4], r1[4];
#pragma unroll
        for (int i = 0; i < 4; ++i) { const int t = tb + 8 * i < tok_hi ? tb + 8 * i : tok_hi - 1; const bf16_t* hp = hres + (size_t)t * 1024 + lane * 16; r0[i] = *(const u32x4*)hp; r1[i] = *(const u32x4*)(hp + 8); }
#pragma unroll
        for (int i = 0; i < 4; ++i) { const u32x4 h0 = r0[i], h1 = r1[i];
            float ss = lo_bf(h0.x) * lo_bf(h0.x) + hi_bf(h0.x) * hi_bf(h0.x) + lo_bf(h0.y) * lo_bf(h0.y) + hi_bf(h0.y) * hi_bf(h0.y) + lo_bf(h0.z) * lo_bf(h0.z) + hi_bf(h0.z) * hi_bf(h0.z) + lo_bf(h0.w) * lo_bf(h0.w) + hi_bf(h0.w) * hi_bf(h0.w)
                     + lo_bf(h1.x) * lo_bf(h1.x) + hi_bf(h1.x) * hi_bf(h1.x) + lo_bf(h1.y) * lo_bf(h1.y) + hi_bf(h1.y) * hi_bf(h1.y) + lo_bf(h1.z) * lo_bf(h1.z) + hi_bf(h1.z) * hi_bf(h1.z) + lo_bf(h1.w) * lo_bf(h1.w) + hi_bf(h1.w) * hi_bf(h1.w);
            ss = wave_sum(ss);
            if (lane == 0 && tb + 8 * i < tok_hi) *(LAS float*)(lds + PE_RSA + (tb + 8 * i - tok_lo) * 4) = rsqrtf(ss * (1.0f / 1024.0f) + 1e-6f); } }
    __syncthreads();
    const bool odd = ((tok_hi - tok_lo) & 1) != 0;
    const int npairs = (tok_hi - tok_lo) / 2;
    int it = (odd && hh == 0) ? -1 : 0;
    for (;;) {
        int tok0 = tok_hi - 1;
        if (it == 0) { int pr = 0; if (lane == 0) pr = __atomic_fetch_add((LAS int*)(lds + MISC_OFF + 80), 1, __ATOMIC_RELAXED); pr = __builtin_amdgcn_readfirstlane(pr);
            if (pr < npairs) tok0 = tok_lo + 2 * pr; else it = 1; }
        const bool coop = it == 1;
        if (coop) { if (!odd) break; __syncthreads(); }
        const bool lo_item = it != 0;
        const int ntok = lo_item ? 1 : 2;
        LAS unsigned char* lle = lo_item ? lds + PE_SLE : lds + PE_LE + hh * 1024; LAS unsigned char* llg = lo_item ? lds + PE_SLG : lds + PE_LG + hh * 1024;
        const int hd_lo = coop ? hh : 0, hd_hi = coop ? hh + 1 : 8;
        int lg = lane; asm volatile("" : "+v"(lg));
        const int l15 = lg & 15, kq = lg >> 4, rowbase = lg & 48;
        const LAS unsigned char* kl = lds + PE_KEYS + l15 * PE_KP + kq * 16;
#ifndef PESEL
#define PESEL 3
#endif
        if ((PESEL & 1) && !coop) {
            const int trow = (l15 >> 3) < ntok ? (l15 >> 3) : ntok - 1;
            const bf16_t* qrow = pq + (size_t)(tok0 + trow) * 2048 + (l15 & 7) * 256;
            unsigned topv[2][4];
#pragma unroll
            for (int p = 0; p < 2; ++p) {
                bf16x8 af[4];
#pragma unroll
                for (int s = 0; s < 4; ++s) af[s] = *(const bf16x8*)(qrow + p * 128 + 32 * s + 8 * kq);
                unsigned v[4][8];
#pragma unroll
                for (int nb = 0; nb < 8; ++nb) { f32x4 acc = (f32x4){0.f, 0.f, 0.f, 0.f}; FENCE();
#pragma unroll
                    for (int s = 0; s < 4; ++s) { const bf16x8 bfr = *(const LAS bf16x8*)(kl + (p * 128 + 16 * nb) * PE_KP + 64 * s);
                        acc = __builtin_amdgcn_mfma_f32_16x16x32_bf16(af[s], bfr, acc, 0, 0, 0); }
#pragma unroll
                    for (int r = 0; r < 4; ++r) v[r][nb] = (f2key(acc[r]) & ~127u) | (unsigned)(16 * nb + l15); }
#pragma unroll
                for (int r = 0; r < 4; ++r) {
                    unsigned* a = v[r];
                    CEX(a[0], a[1]); CEX(a[2], a[3]); CEX(a[4], a[5]); CEX(a[6], a[7]);
                    CEX(a[0], a[2]); CEX(a[1], a[3]); CEX(a[4], a[6]); CEX(a[5], a[7]);
                    CEX(a[1], a[2]); CEX(a[5], a[6]);
                    CEX(a[0], a[4]); CEX(a[1], a[5]); CEX(a[2], a[6]); CEX(a[3], a[7]);
                    CEX(a[2], a[4]); CEX(a[3], a[5]);
                    CEX(a[1], a[2]); CEX(a[3], a[4]); CEX(a[5], a[6]);
                    unsigned top = 0u;
#pragma unroll
                    for (int k = 0; k < 16; ++k) { const unsigned mx = rowmax_u(a[0]); top = (l15 == k) ? mx : top; const bool pop = a[0] == mx;
#pragma unroll
                        for (int j = 0; j < 7; ++j) a[j] = pop ? a[j + 1] : a[j];
                        a[7] = pop ? 0u : a[7]; }
                    topv[p][r] = top; }
            }
#pragma unroll
            for (int r = 0; r < 4; ++r) {
                unsigned cnd[4];
                const unsigned cellpk_ = *(const LAS unsigned*)(lds + PE_CELL + F.lane * 8), cellvalid_ = *(const LAS unsigned*)(lds + PE_CELL + F.lane * 8 + 4);
#pragma unroll
                for (int sl = 0; sl < 4; ++sl) { const int ij = (cellpk_ >> (8 * sl)) & 255, i = ij >> 4, j = ij & 15;
                    const unsigned ka = (unsigned)__builtin_amdgcn_ds_bpermute((rowbase + i) * 4, (int)topv[0][r]), kb = (unsigned)__builtin_amdgcn_ds_bpermute((rowbase + j) * 4, (int)topv[1][r]);
                    const float sum = key2f(ka) + key2f(kb);
                    cnd[sl] = ((cellvalid_ >> sl) & 1u) ? ((f2key(sum) & ~255u) | (unsigned)ij) : 0u; }
                CEX(cnd[0], cnd[1]); CEX(cnd[2], cnd[3]); CEX(cnd[0], cnd[2]); CEX(cnd[1], cnd[3]); CEX(cnd[1], cnd[2]);
                unsigned win = 0u;
#pragma unroll
                for (int k = 0; k < 16; ++k) { const unsigned mx = rowmax_u(cnd[0]); win = (l15 == k) ? mx : win; const bool pop = cnd[0] == mx;
                    cnd[0] = pop ? cnd[1] : cnd[0]; cnd[1] = pop ? cnd[2] : cnd[1]; cnd[2] = pop ? cnd[3] : cnd[2]; cnd[3] = pop ? 0u : cnd[3]; }
                const int wi = (win >> 4) & 15, wj = win & 15;
                const unsigned ka = (unsigned)__builtin_amdgcn_ds_bpermute((rowbase + wi) * 4, (int)topv[0][r]), kb = (unsigned)__builtin_amdgcn_ds_bpermute((rowbase + wj) * 4, (int)topv[1][r]);
                const int eidx = (int)((ka & 127u) * 128u + (kb & 127u));
                const float sv = key2f(win), smax = key2f(rowmax_u(win));
                const int rho = 4 * kq + r;
                const float rst = *(const LAS float*)(lds + PE_RSA + (tok0 - tok_lo + ((rho >> 3) < ntok ? (rho >> 3) : 0)) * 4);
                const float e = fexp2((sv - smax) * (rst * LOG2E)), den = rowsum_f(e), gk = e / den;
                *(LAS int*)(lle + (rho * 16 + l15) * 4) = eidx;
                *(LAS float*)(llg + (rho * 16 + l15) * 4) = gk;
            }
        }
        if ((PESEL & 2) && it >= 0) for (int tl = 0; tl < ntok; ++tl) {
            const int t = tok0 + tl;
            int ln = lane; asm volatile("" : "+v"(ln));
            const u32x4 h0 = *(const u32x4*)(hres + (size_t)t * 1024 + ln * 16), h1 = *(const u32x4*)(hres + (size_t)t * 1024 + ln * 16 + 8);
            const unsigned hp8[8] = {h0.x, h0.y, h0.z, h0.w, h1.x, h1.y, h1.z, h1.w};
            i32x8 xB;
            { LAS unsigned char* xscr = lds + PE_XS + hh * 1024;
              const float rst = *(const LAS float*)(lds + PE_RSA + (tok0 - tok_lo + tl) * 4);
              float xv[16];
#pragma unroll
              for (int q = 0; q < 8; ++q) { const f32x2 gg = *(const f32x2*)(gffn + ln * 16 + 2 * q); xv[2 * q] = lo_bf(hp8[q]) * rst * gg.x; xv[2 * q + 1] = hi_bf(hp8[q]) * rst * gg.y; }
              u32x4 xb;
#pragma unroll
              for (int d4 = 0; d4 < 4; ++d4) { int w_ = 0; w_ = __builtin_amdgcn_cvt_pk_fp8_f32(xv[4 * d4], xv[4 * d4 + 1], w_, false); w_ = __builtin_amdgcn_cvt_pk_fp8_f32(xv[4 * d4 + 2], xv[4 * d4 + 3], w_, true); xb[d4] = (unsigned)w_; }
              *(LAS u32x4*)(xscr + ln * 16) = xb;
              asm volatile("s_waitcnt lgkmcnt(0)" ::: "memory");
              const int n_ = ln & 15, kq_ = ln >> 4;
              const u32x4 b0 = *(const LAS u32x4*)(xscr + (8 * kq_ + n_) * 16), b1 = *(const LAS u32x4*)(xscr + (32 + 8 * kq_ + n_) * 16);
              const bool bz = (kq_ & 1) != 0;
              xB = (i32x8){bz ? 0 : (int)b0.x, bz ? 0 : (int)b0.y, bz ? 0 : (int)b0.z, bz ? 0 : (int)b0.w, bz ? 0 : (int)b1.x, bz ? 0 : (int)b1.y, bz ? 0 : (int)b1.z, bz ? 0 : (int)b1.w}; }
            const bool dvalid = ((ln & 15) >> 2) == (ln >> 4);
            float dm0 = (dvalid && (ln & 3) == 0) ? 1.f : 0.f, dm1 = (dvalid && (ln & 3) == 1) ? 1.f : 0.f, dm2 = (dvalid && (ln & 3) == 2) ? 1.f : 0.f, dm3 = (dvalid && (ln & 3) == 3) ? 1.f : 0.f;
            asm volatile("" : "+v"(dm0), "+v"(dm1), "+v"(dm2), "+v"(dm3));
            h2_t oa[8];
#pragma unroll
            for (int j = 0; j < 8; ++j) oa[j] = (h2_t){(_Float16)0.f, (_Float16)0.f};
            const int ksel = ((ln >> 2) & 3) + 4 * ((ln >> 4) & 1) + 8 * (ln >> 5);
            u32x4 ruA[16], ruB[16]; float uselA, vselA, uselB, vselB;
#define PE_ISSUE(X, hd_) do { int es[16]; \
                _Pragma("unroll") for (int i4 = 0; i4 < 4; ++i4) { const u32x4 ev = *(const LAS u32x4*)(lle + ((tl * 8 + (hd_)) * 16 + 4 * i4) * 4); \
                    es[4 * i4] = __builtin_amdgcn_readfirstlane((int)ev.x); es[4 * i4 + 1] = __builtin_amdgcn_readfirstlane((int)ev.y); es[4 * i4 + 2] = __builtin_amdgcn_readfirstlane((int)ev.z); es[4 * i4 + 3] = __builtin_amdgcn_readfirstlane((int)ev.w); } \
                _Pragma("unroll") for (int k = 0; k < 16; ++k) ru##X[k] = __builtin_bit_cast(u32x4, __builtin_amdgcn_raw_buffer_load_b128(uvrsrc, ln * 16, es[k] * 1024, 0)); \
                const int esel = *(const LAS int*)(lle + ((tl * 8 + (hd_)) * 16 + ksel) * 4); \
                usel##X = usc[esel]; vsel##X = vsc[esel]; } while (0)
#define PE_DOT(X, k_) ({ const f32x4 dd = __builtin_amdgcn_mfma_scale_f32_16x16x128_f8f6f4((i32x8){(int)ru##X[k_].x, (int)ru##X[k_].y, (int)ru##X[k_].z, (int)ru##X[k_].w, 0, 0, 0, 0}, xB, (f32x4){0.f, 0.f, 0.f, 0.f}, 4, 0, 0, 0x7f7f7f7f, 0, 0x7f7f7f7f); \
                    dd[0] * dm0 + dd[1] * dm1 + dd[2] * dm2 + dd[3] * dm3; })
#define PE_COMPUTE(X, hd_) do { \
                const float gsel_ = *(const LAS float*)(llg + ((tl * 8 + (hd_)) * 16 + ksel) * 4); float wsel; \
                { float a8[8], b4[4]; \
                    _Pragma("unroll") for (int k = 0; k < 8; ++k) { const float dlo = PE_DOT(X, k), dhi = PE_DOT(X, k + 8); const auto r_ = __builtin_amdgcn_permlane32_swap(__float_as_uint(dlo), __float_as_uint(dhi), false, false); a8[k] = __uint_as_float(r_[0]) + __uint_as_float(r_[1]); } \
                    _Pragma("unroll") for (int k = 0; k < 4; ++k) { const auto r_ = __builtin_amdgcn_permlane16_swap(__float_as_uint(a8[k]), __float_as_uint(a8[k + 4]), false, false); b4[k] = rowsum_f(__uint_as_float(r_[0]) + __uint_as_float(r_[1])); } \
                    const int jj = (ln >> 2) & 3; \
                    const float d1 = jj == 0 ? b4[0] : jj == 1 ? b4[1] : jj == 2 ? b4[2] : b4[3]; \
                    wsel = gsel_ * gelu_tanh(d1 * usel##X) * vsel##X; } \
                const int wselh = (int)__builtin_bit_cast(unsigned short, (_Float16)wsel); \
                _Pragma("unroll") for (int k = 0; k < 16; ++k) { const int wb = __builtin_amdgcn_readlane(wselh, 16 * (((k >> 2) & 1) + 2 * (k >> 3)) + 4 * (k & 3)); \
                    const _Float16 wh = __builtin_bit_cast(_Float16, (unsigned short)wb); const h2_t wv = (h2_t){wh, wh}; \
                    h2_t c[8]; \
                    c[0] = __builtin_amdgcn_cvt_scalef32_pk_f16_fp4(ru##X[k].z, 1.0f, 0); c[1] = __builtin_amdgcn_cvt_scalef32_pk_f16_fp4(ru##X[k].z, 1.0f, 1); c[2] = __builtin_amdgcn_cvt_scalef32_pk_f16_fp4(ru##X[k].z, 1.0f, 2); c[3] = __builtin_amdgcn_cvt_scalef32_pk_f16_fp4(ru##X[k].z, 1.0f, 3); \
                    c[4] = __builtin_amdgcn_cvt_scalef32_pk_f16_fp4(ru##X[k].w, 1.0f, 0); c[5] = __builtin_amdgcn_cvt_scalef32_pk_f16_fp4(ru##X[k].w, 1.0f, 1); c[6] = __builtin_amdgcn_cvt_scalef32_pk_f16_fp4(ru##X[k].w, 1.0f, 2); c[7] = __builtin_amdgcn_cvt_scalef32_pk_f16_fp4(ru##X[k].w, 1.0f, 3); \
                    _Pragma("unroll") for (int q = 0; q < 8; ++q) oa[q] = c[q] * wv + oa[q]; } } while (0)
            PE_ISSUE(A, hd_lo);
            int hd = hd_lo;
#pragma unroll 1
            for (; hd + 2 < hd_hi; hd += 2) {
                PE_ISSUE(B, hd + 1); __builtin_amdgcn_sched_barrier(0);
                PE_COMPUTE(A, hd); __builtin_amdgcn_sched_barrier(0);
                PE_ISSUE(A, hd + 2); __builtin_amdgcn_sched_barrier(0);
                PE_COMPUTE(B, hd + 1); __builtin_amdgcn_sched_barrier(0);
            }
            if (hd + 1 < hd_hi) { PE_ISSUE(B, hd + 1); __builtin_amdgcn_sched_barrier(0); PE_COMPUTE(A, hd); __builtin_amdgcn_sched_barrier(0); PE_COMPUTE(B, hd + 1); }
            else { __builtin_amdgcn_sched_barrier(0); PE_COMPUTE(A, hd); }
#undef PE_ISSUE
#undef PE_COMPUTE
#undef PE_DOT
            float oaf[16];
#pragma unroll
            for (int q = 0; q < 8; ++q) { oaf[2 * q] = (float)oa[q].x; oaf[2 * q + 1] = (float)oa[q].y; }
            bool fin = true;
            if (coop) {
#pragma unroll
                for (int j4 = 0; j4 < 4; ++j4) *(LAS f32x4*)(lds + PE_COOP + hh * 4096 + ln * 64 + j4 * 16) = (f32x4){oaf[4 * j4], oaf[4 * j4 + 1], oaf[4 * j4 + 2], oaf[4 * j4 + 3]};
                __syncthreads();
                fin = hh == 0;
                if (fin) {
#pragma unroll
                    for (int j = 0; j < 16; ++j) oaf[j] = 0.f;
#pragma unroll
                    for (int w8 = 0; w8 < 8; ++w8)
#pragma unroll
                        for (int j4 = 0; j4 < 4; ++j4) { const f32x4 pv4 = *(const LAS f32x4*)(lds + PE_COOP + w8 * 4096 + ln * 64 + j4 * 16); oaf[4 * j4] += pv4[0]; oaf[4 * j4 + 1] += pv4[1]; oaf[4 * j4 + 2] += pv4[2]; oaf[4 * j4 + 3] += pv4[3]; } } }
            if (fin) {
                float acc[16];
#pragma unroll
                for (int q = 0; q < 8; ++q) { acc[2 * q] = lo_bf(hp8[q]) + oaf[2 * q]; acc[2 * q + 1] = hi_bf(hp8[q]) + oaf[2 * q + 1]; }
                float ss = 0.f;
#pragma unroll
                for (int j = 0; j < 16; ++j) ss += acc[j] * acc[j];
                ss = wave_sum(ss);
                const float rs = rsqrtf(ss * (1.0f / 1024.0f) + 1e-6f);
                if (F.dry) {}
                else if (FINAL) { const int b = t / LTOK, l = t - b * LTOK;
                    if (l >= NMETA) { float* op = F.out + ((size_t)b * SEQ + (l - NMETA)) * 1024 + ln * 16;
                        f32x4 ggs[4];
#pragma unroll
                        for (int j4 = 0; j4 < 4; ++j4) ggs[j4] = *(const f32x4*)(gnext + ln * 16 + 4 * j4);
                        FENCE();
#pragma unroll
                        for (int j4 = 0; j4 < 4; ++j4) { const f32x4 gg = ggs[j4];
                            *(f32x4*)(op + 4 * j4) = (f32x4){acc[4 * j4] * rs * gg[0], acc[4 * j4 + 1] * rs * gg[1], acc[4 * j4 + 2] * rs * gg[2], acc[4 * j4 + 3] * rs * gg[3]}; } } }
                else {
                    u32x4 w0, w1; w0.x = cvt_pk_bf16(acc[0], acc[1]); w0.y = cvt_pk_bf16(acc[2], acc[3]); w0.z = cvt_pk_bf16(acc[4], acc[5]); w0.w = cvt_pk_bf16(acc[6], acc[7]);
                    w1.x = cvt_pk_bf16(acc[8], acc[9]); w1.y = cvt_pk_bf16(acc[10], acc[11]); w1.z = cvt_pk_bf16(acc[12], acc[13]); w1.w = cvt_pk_bf16(acc[14], acc[15]);
                    *(u32x4*)(hout + (size_t)t * 1024 + ln * 16) = w0; *(u32x4*)(hout + (size_t)t * 1024 + ln * 16 + 8) = w1;
                    if (ln == 0) rs2[t] = rs; }
            }
        }
        if (coop) break;
        if (it < 0) it = 0;
    }
}

__device__ __forceinline__ void conv_phase(const Frame& F) {
    PLACE(PAD_S);
    const bf16_t* xr = WSP(bf16_t, WS_RB + U1); bf16_t* xc = WSP(bf16_t, WS_RA); const float* cw = F.in[13]; const float* cb = F.in[14];
    const int gtid = F.bid * NTHREADS + F.tid, gsz = F.G * NTHREADS;
    u32x4 wn[4];
    auto ld = [&](int idx) { const int t = idx >> 7, c8 = (idx & 127) * 8, l = t % LTOK;
#pragma unroll
        for (int j = 0; j < 4; ++j) { const int dl = 3 - j; wn[j] = (l - dl >= 0) ? *(const u32x4*)(xr + (size_t)(t - dl) * 1024 + c8) : (u32x4){0u, 0u, 0u, 0u}; } };
    const int c8 = (gtid & 127) * 8;
    float cwr[4][8], cbr[8];
#pragma unroll
    for (int q = 0; q < 8; ++q) { cbr[q] = cb[c8 + q];
#pragma unroll
        for (int j = 0; j < 4; ++j) cwr[j][q] = cw[j * 1024 + c8 + q]; }
    if (gtid < T * 128) ld(gtid);
    for (int idx = gtid; idx < T * 128; idx += gsz) { const int t = idx >> 7;
        u32x4 wc4[4];
#pragma unroll
        for (int j = 0; j < 4; ++j) wc4[j] = wn[j];
        if (idx + gsz < T * 128) ld(idx + gsz);
        float acc[8];
#pragma unroll
        for (int q = 0; q < 8; ++q) acc[q] = cbr[q];
#pragma unroll
        for (int j = 0; j < 4; ++j) { const u32x4 w = wc4[j];
            const float xv[8] = {lo_bf(w.x), hi_bf(w.x), lo_bf(w.y), hi_bf(w.y), lo_bf(w.z), hi_bf(w.z), lo_bf(w.w), hi_bf(w.w)};
#pragma unroll
            for (int q = 0; q < 8; ++q) acc[q] += xv[q] * cwr[j][q]; }
        u32x4 o; o.x = cvt_pk_bf16(acc[0], acc[1]); o.y = cvt_pk_bf16(acc[2], acc[3]); o.z = cvt_pk_bf16(acc[4], acc[5]); o.w = cvt_pk_bf16(acc[6], acc[7]);
        *(u32x4*)(xc + (size_t)t * 1024 + c8) = o; }
}
template <int PASS>
__device__ __forceinline__ void scan_phase(const Frame& F) {
    PLACE(PAD_S);
    const bf16_t* la = DOP(bf16_t, 0); const bf16_t* ix = WSP(bf16_t, WS_RB + U1); const bf16_t* gate = WSP(bf16_t, WS_RB); bf16_t* y = WSP(bf16_t, WS_RA);
    float* agg = WSP(float, WS_AGG);
    const int gtid = F.bid * NTHREADS + F.tid, gsz = F.G * NTHREADS;
    for (int idx = gtid; idx < BATCH * NCHUNK * 128; idx += gsz) { const int cg = idx & 127, bc = idx >> 7, ch = bc % NCHUNK, b = bc / NCHUNK, c8 = cg * 8;
        float hst[8], ap[8];
#pragma unroll
        for (int q = 0; q < 8; ++q) { hst[q] = 0.f; ap[q] = 1.f; }
        if (PASS == 2) { for (int cc = 0; cc < ch; ++cc) { const float* ag = agg + ((size_t)(b * NCHUNK + cc) * 2) * 1024 + c8;
                const f32x4 a0 = *(const f32x4*)ag, a1 = *(const f32x4*)(ag + 4), e0 = *(const f32x4*)(ag + 1024), e1 = *(const f32x4*)(ag + 1028);
#pragma unroll
                for (int q = 0; q < 4; ++q) { hst[q] = a0[q] * hst[q] + e0[q]; hst[4 + q] = a1[q] * hst[4 + q] + e1[q]; } } }
        const size_t t0 = (size_t)b * LTOK + (size_t)ch * CHUNK;
        u32x4 lwA[4], iwA[4], gwA[4], lwB[4], iwB[4], gwB[4];
#define SCAN_LD(X, NB, s0) do { _Pragma("unroll") for (int j = 0; j < NB; ++j) { const size_t off = (t0 + (s0) + j) * 1024 + c8; lw##X[j] = *(const u32x4*)(la + off); iw##X[j] = *(const u32x4*)(ix + off); if (PASS == 2) gw##X[j] = *(const u32x4*)(gate + off); } } while (0)
#define SCAN_CP(X, NB, s0) do { _Pragma("unroll") for (int j = 0; j < NB; ++j) { const u32x4 lw = lw##X[j], iw = iw##X[j]; \
                const float lv[8] = {lo_bf(lw.x), hi_bf(lw.x), lo_bf(lw.y), hi_bf(lw.y), lo_bf(lw.z), hi_bf(lw.z), lo_bf(lw.w), hi_bf(lw.w)}; \
                const float iv[8] = {lo_bf(iw.x), hi_bf(iw.x), lo_bf(iw.y), hi_bf(iw.y), lo_bf(iw.z), hi_bf(iw.z), lo_bf(iw.w), hi_bf(iw.w)}; \
                _Pragma("unroll") for (int q = 0; q < 8; ++q) { const float a = fexp2(lv[q] * LOG2E); const float mult = sqrtf(fmaxf(1.0f - a * a, 0.f)); hst[q] = a * hst[q] + mult * iv[q]; if (PASS == 1) ap[q] *= a; } \
                if (PASS == 2) { const u32x4 gw = gw##X[j]; \
                    u32x4 o; o.x = cvt_pk_bf16(hst[0] * lo_bf(gw.x), hst[1] * hi_bf(gw.x)); o.y = cvt_pk_bf16(hst[2] * lo_bf(gw.y), hst[3] * hi_bf(gw.y)); \
                    o.z = cvt_pk_bf16(hst[4] * lo_bf(gw.z), hst[5] * hi_bf(gw.z)); o.w = cvt_pk_bf16(hst[6] * lo_bf(gw.w), hst[7] * hi_bf(gw.w)); \
                    *(u32x4*)(y + (t0 + (s0) + j) * 1024 + c8) = o; } } } while (0)
        static_assert(CHUNK == 43, "scan batching below is written for 43-step chunks: 10 x 4 + 3");
        SCAN_LD(A, 4, 0);
#define SCAN_BODY(s0) do { SCAN_LD(B, 4, (s0) + 4); FENCE(); SCAN_CP(A, 4, (s0)); FENCE(); if ((s0) + 8 < 40) SCAN_LD(A, 4, (s0) + 8); else SCAN_LD(A, 3, 40); FENCE(); SCAN_CP(B, 4, (s0) + 4); FENCE(); } while (0)
        if (PASS == 2) {
            SCAN_BODY(0); SCAN_BODY(8); SCAN_BODY(16); SCAN_BODY(24); SCAN_BODY(32);
        } else {
#pragma unroll 1
            for (int s0 = 0; s0 < 40; s0 += 8) SCAN_BODY(s0);
        }
#undef SCAN_BODY
        SCAN_CP(A, 3, 40);
#undef SCAN_LD
#undef SCAN_CP
        if (PASS == 1) { float* ag = agg + ((size_t)(b * NCHUNK + ch) * 2) * 1024 + c8;
            *(f32x4*)ag = (f32x4){ap[0], ap[1], ap[2], ap[3]}; *(f32x4*)(ag + 4) = (f32x4){ap[4], ap[5], ap[6], ap[7]};
            *(f32x4*)(ag + 1024) = (f32x4){hst[0], hst[1], hst[2], hst[3]}; *(f32x4*)(ag + 1028) = (f32x4){hst[4], hst[5], hst[6], hst[7]}; }
    }
}

__global__ void __launch_bounds__(NTHREADS, 2) mega(Args args) {
    extern __shared__ __attribute__((aligned(16))) unsigned char lds_raw[];
    Frame F; F.lds = (LAS unsigned char*)lds_raw; F.tid = threadIdx.x; F.lane = F.tid & 63; F.wave = __builtin_amdgcn_readfirstlane(F.tid >> 6); F.G = gridDim.x; F.bid = blockIdx.x;
    F.in = args.in; F.out = args.out; F.ws = args.ws; F.ctl = (unsigned*)(args.ws + WS_CTL); F.dry = args.dry;
    volatile LAS unsigned* misc = (volatile LAS unsigned*)(F.lds + MISC_OFF);
    if (F.tid < 64) misc[F.tid] = 0u;
    __syncthreads();
    const int lo = args.ph_lo, hi = args.ph_hi;
    const bool multi = (hi - lo) > 1;
    XcdBarrier bar; bar.bar = F.ctl + CW_BAR; bar.x = 0; bar.st = misc;
    if (multi) bar = xcd_barrier_post(F.ctl + CW_BAR, misc);
#ifndef PHMASK
#define PHMASK 0xffff
#endif
#define IN(k) (((PHMASK >> (k)) & 1) && lo <= (k) && (k) < hi)
#define SEAM(k) do { if (IN(k) && IN((k) + 1)) xcd_barrier(bar); } while (0)
    LAS unsigned char* L = F.lds;
    if (IN(0)) { p0_prologue(F); } SEAM(0);
    if (IN(1)) { pg8::Gemm g{WSP(bf16_t, WS_RA), WSP(bf16_t, WS_WIN0), T, 768, 1024, 1024, 0, 0}; pg8::StaticOrder S; S.init(T, 768, F.G, F.bid);
        pg8::EpiBf16 E{WSP(bf16_t, WS_RB), 768}; pg8::gemm_phase(L, g, S, E);
        { const int n2 = P1_UNITS - F.G; const bool split = n2 > 0 && n2 + 32 < F.G;
          if (split && F.bid >= n2) { __syncthreads(); conv_tables(F, 16384, 2 * 16384, F.bid - n2, F.G - n2); } } } SEAM(1);
    if (IN(2)) { latnorm_phase(F); } SEAM(2);
    if (IN(3)) {
#ifndef P3SEL
#define P3SEL 7
#endif
        if (P3SEL & 1) { pg8::Gemm g{DOP(bf16_t, DO_QN), WSP(bf16_t, WS_WQUP), TMAIN, 1536, 384, 384, 0, 0}; pg8::StaticOrder S; S.init(TMAIN, 1536, F.G, F.bid);
          pg8::EpiBf16 E{WSP(bf16_t, WS_H), 1536}; pg8::gemm_phase(L, g, S, E); }
        if (P3SEL & 2) { pg8::Gemm g{DOP(bf16_t, DO_KVN), WSP(bf16_t, WS_WK), TMAIN, 1024, 256, 256, 0, 0}; pg8::StaticOrder S; S.init(TMAIN, 1024, F.G, F.bid);
          pg8::EpiBf16 E{DOP(bf16_t, DO_KN), 1024}; pg8::gemm_phase(L, g, S, E); }
        if (P3SEL & 4) { pg8::Gemm g{WSP(bf16_t, WS_WV), DOP(bf16_t, DO_KVN), 1024, TMAIN, 256, 256, 0, 0}; pg8::StaticOrder S; S.init(1024, TMAIN, F.G, F.bid);
          pg8::EpiBf16 E{WSP(bf16_t, WS_RB + U1), T}; pg8::gemm_phase(L, g, S, E); }
        { const int kq = F.lane >> 4, l15 = F.lane & 15;
          { bf16_t* o = WSP(bf16_t, WS_H) + (size_t)TMAIN * 1536;
            coop_gemm(F, DOP(bf16_t, DO_QN) + (size_t)TMAIN * 384, 384, WSP(bf16_t, WS_WQUP), 384, 384, TREM / 16, 1536 / 16, [](int) { return 0; }, [=](int rt, int ct, f32x4 a) {
#pragma unroll
                for (int i = 0; i < 4; ++i) o[(size_t)(rt * 16 + 4 * kq + i) * 1536 + ct * 16 + l15] = f2bf(a[i]); }); }
          { bf16_t* o = DOP(bf16_t, DO_KN) + (size_t)TMAIN * 1024;
            coop_gemm(F, DOP(bf16_t, DO_KVN) + (size_t)TMAIN * 256, 256, WSP(bf16_t, WS_WK), 256, 256, TREM / 16, 1024 / 16, [](int) { return 0; }, [=](int rt, int ct, f32x4 a) {
#pragma unroll
                for (int i = 0; i < 4; ++i) o[(size_t)(rt * 16 + 4 * kq + i) * 1024 + ct * 16 + l15] = f2bf(a[i]); }); }
          { bf16_t* o = WSP(bf16_t, WS_RB + U1) + TMAIN;
            coop_gemm(F, WSP(bf16_t, WS_WV), 256, DOP(bf16_t, DO_KVN) + (size_t)TMAIN * 256, 256, 256, 1024 / 16, TREM / 16, [](int) { return 0; }, [=](int rt, int ct, f32x4 a) {
#pragma unroll
                for (int i = 0; i < 4; ++i) o[(size_t)(rt * 16 + 4 * kq + i) * T + ct * 16 + l15] = f2bf(a[i]); }); } }
    } SEAM(3);
    if (IN(4)) { attn_phase(F); } SEAM(4);
    if (IN(5)) { pg8::Gemm g{WSP(bf16_t, WS_RA), WSP(bf16_t, WS_WOUT0), TMAIN, 1024, 1024, 1024, 0, 0}; pg8::StaticOrder S; S.init(TMAIN, 1024, F.G, F.bid);
        pg8::EpiResX E{WSP(bf16_t, WS_H), F.in[0], F.in[2]}; pg8::gemm_phase(L, g, S, E);
        { bf16_t* hh_ = WSP(bf16_t, WS_H); const int kq = F.lane >> 4, l15 = F.lane & 15; const Frame Fc = F;
          coop_gemm(F, WSP(bf16_t, WS_RA) + (size_t)TMAIN * 1024, 1024, WSP(bf16_t, WS_WOUT0), 1024, 1024, TREM / 16, 1024 / 16, [](int) { return 0; }, [=](int rt, int ct, f32x4 a) {
#pragma unroll
              for (int i = 0; i < 4; ++i) { const int t = TMAIN + rt * 16 + 4 * kq + i, c = ct * 16 + l15; hh_[(size_t)t * 1024 + c] = f2bf(h0_row(Fc, t)[c] + a[i]); } }); } } SEAM(5);
    if (IN(6)) { pg8::Gemm g{WSP(bf16_t, WS_H), WSP(bf16_t, WS_WPQ), TMAIN, 2048, 1024, 1024, 0, 0}; pg8::StaticOrder S; S.init(TMAIN, 2048, F.G, F.bid);
        pg8::EpiBf16 E{WSP(bf16_t, WS_RB), 2048}; pg8::gemm_phase(L, g, S, E);
        { bf16_t* o = WSP(bf16_t, WS_RB) + (size_t)TMAIN * 2048; const int kq = F.lane >> 4, l15 = F.lane & 15;
          coop_gemm(F, WSP(bf16_t, WS_H) + (size_t)TMAIN * 1024, 1024, WSP(bf16_t, WS_WPQ), 1024, 1024, TREM / 16, 2048 / 16, [](int) { return 0; }, [=](int rt, int ct, f32x4 a) {
#pragma unroll
              for (int i = 0; i < 4; ++i) o[(size_t)(rt * 16 + 4 * kq + i) * 2048 + ct * 16 + l15] = f2bf(a[i]); }); } } SEAM(6);
    if (IN(7)) { peer_phase<false>(F, 0); } SEAM(7);
    if (IN(8)) { pg8::Gemm g{WSP(bf16_t, WS_H2), WSP(bf16_t, WS_WLIN), TMAIN, 2048, 1024, 1024, 0, 0}; pg8::StaticOrder S; S.init(TMAIN, 2048, F.G, F.bid);
        pg8::EpiLruIn E{WSP(bf16_t, WS_RB), WSP(bf16_t, WS_RB + U1), WSP(float, WS_RS2)}; pg8::gemm_phase(L, g, S, E);
        { bf16_t* og = WSP(bf16_t, WS_RB) + (size_t)TMAIN * 1024; bf16_t* ox = WSP(bf16_t, WS_RB + U1) + (size_t)TMAIN * 1024; const float* rsr = WSP(float, WS_RS2) + TMAIN; const int kq = F.lane >> 4, l15 = F.lane & 15;
          coop_gemm(F, WSP(bf16_t, WS_H2) + (size_t)TMAIN * 1024, 1024, WSP(bf16_t, WS_WLIN), 1024, 1024, TREM / 16, 2048 / 16, [](int) { return 0; }, [=](int rt, int ct, f32x4 a) {
              const int c = ct * 16 + l15;
#pragma unroll
              for (int i = 0; i < 4; ++i) { const int rr = rt * 16 + 4 * kq + i; const size_t ro = (size_t)rr * 1024; const float v = a[i] * rsr[rr]; if (c < 1024) og[ro + c] = f2bf(gelu_tanh(v)); else ox[ro + c - 1024] = f2bf(v); } }); } } SEAM(8);
    if (IN(9)) { conv_phase(F); } SEAM(9);
    if (IN(10)) { pg8::Gemm g{WSP(bf16_t, WS_RA), WSP(bf16_t, WS_WGATE), TMAIN, 2048, 256, 1024, 1, 256}; pg8::StaticOrder S; S.init(TMAIN, 2048, F.G, F.bid);
        pg8::EpiGate E{DOP(bf16_t, 0), WSP(bf16_t, WS_RB + U1), WSP(bf16_t, WS_RA), WSP(float, WS_LRUC)}; pg8::gemm_phase<pg8::EpiGate, false, false>(L, g, S, E);
        { bf16_t* ola = DOP(bf16_t, 0) + (size_t)TMAIN * 1024; bf16_t* oix = WSP(bf16_t, WS_RB + U1) + (size_t)TMAIN * 1024; const bf16_t* xcp = WSP(bf16_t, WS_RA) + (size_t)TMAIN * 1024;
          const float* lc = WSP(float, WS_LRUC); const int kq = F.lane >> 4, l15 = F.lane & 15;
          coop_gemm(F, xcp, 1024, WSP(bf16_t, WS_WGATE), 256, 256, TREM / 16, 2048 / 16, [](int ct) { return 256 * ((ct >> 4) >> 1); }, [=](int rt, int ct, f32x4 a) {
              const int j = ct >> 4, cl = (ct & 15) * 16 + l15, e = cl & 127, ch = j * 128 + e; const bool isx = cl >= 128;
#pragma unroll
              for (int i = 0; i < 4; ++i) { const size_t ro = (size_t)(rt * 16 + 4 * kq + i) * 1024 + ch;
                  if (isx) oix[ro] = f2bf(sigmoidf_(a[i] + lc[1024 + ch]) * bf2f(xcp[ro])); else ola[ro] = f2bf(-lc[2048 + ch] * sigmoidf_(a[i] + lc[ch])); } }); } } SEAM(10);
    if (IN(11)) { scan_phase<1>(F); } SEAM(11);
    if (IN(12)) { scan_phase<2>(F); } SEAM(12);
    if (IN(13)) { pg8::Gemm g{WSP(bf16_t, WS_RA), WSP(bf16_t, WS_WLOUT), TMAIN, 1024, 1024, 1024, 0, 0}; pg8::StaticOrder S; S.init(TMAIN, 1024, F.G, F.bid);
        const float rsc = F.dry ? 0.0f : 1.0f;
        pg8::EpiResB E{WSP(bf16_t, WS_H), WSP(bf16_t, WS_H2), rsc}; pg8::gemm_phase(L, g, S, E);
        { bf16_t* hh_ = WSP(bf16_t, WS_H) + (size_t)TMAIN * 1024; const bf16_t* hb_ = WSP(bf16_t, WS_H2) + (size_t)TMAIN * 1024; const int kq = F.lane >> 4, l15 = F.lane & 15;
          coop_gemm(F, WSP(bf16_t, WS_RA) + (size_t)TMAIN * 1024, 1024, WSP(bf16_t, WS_WLOUT), 1024, 1024, TREM / 16, 1024 / 16, [](int) { return 0; }, [=](int rt, int ct, f32x4 a) {
#pragma unroll
              for (int i = 0; i < 4; ++i) { const size_t o_ = (size_t)(rt * 16 + 4 * kq + i) * 1024 + ct * 16 + l15; hh_[o_] = f2bf(bf2f(hb_[o_]) + a[i] * rsc); } }); } } SEAM(13);
    if (IN(14)) { pg8::Gemm g{WSP(bf16_t, WS_H), WSP(bf16_t, WS_WPQ) + (size_t)2048 * 1024, TMAIN, 2048, 1024, 1024, 0, 0}; pg8::StaticOrder S; S.init(TMAIN, 2048, F.G, F.bid);
        pg8::EpiBf16 E{WSP(bf16_t, WS_RB), 2048}; pg8::gemm_phase(L, g, S, E);
        { bf16_t* o = WSP(bf16_t, WS_RB) + (size_t)TMAIN * 2048; const int kq = F.lane >> 4, l15 = F.lane & 15;
          coop_gemm(F, WSP(bf16_t, WS_H) + (size_t)TMAIN * 1024, 1024, WSP(bf16_t, WS_WPQ) + (size_t)2048 * 1024, 1024, 1024, TREM / 16, 2048 / 16, [](int) { return 0; }, [=](int rt, int ct, f32x4 a) {
#pragma unroll
              for (int i = 0; i < 4; ++i) o[(size_t)(rt * 16 + 4 * kq + i) * 2048 + ct * 16 + l15] = f2bf(a[i]); }); } } SEAM(14);
    if (IN(15)) { peer_phase<true>(F, 1); }
#undef IN
#undef SEAM
}

#ifndef MK_ONE_LAUNCH
#define MK_ONE_LAUNCH 1
#endif
#ifndef PROBE_DUP
#define PROBE_DUP 0
#endif
extern "C" void kernel_launch(void* const* d_in, const int* in_sizes, int n_in, void* d_out, int out_size, void* d_ws, size_t ws_size, hipStream_t stream) {
    static int grid = 0;
    if (grid == 0) {
        if (n_in != 25 || out_size != BATCH * SEQ * D || ws_size < WS_END) { fprintf(stderr, "kernel_launch: unexpected shapes (n_in %d out %d ws %zu need %zu)\n", n_in, out_size, ws_size, (size_t)WS_END); grid = -1; return; }
        int dev = 0, cus = 0, per_cu = 0;
        if (hipGetDevice(&dev) != hipSuccess || hipDeviceGetAttribute(&cus, hipDeviceAttributeMultiprocessorCount, dev) != hipSuccess) { grid = -1; return; }
        if (hipFuncSetAttribute((const void*)mega, hipFuncAttributeMaxDynamicSharedMemorySize, LDS_BYTES) != hipSuccess) { fprintf(stderr, "kernel_launch: hipFuncSetAttribute failed\n"); grid = -1; return; }
        if (hipOccupancyMaxActiveBlocksPerMultiprocessor(&per_cu, (const void*)mega, NTHREADS, LDS_BYTES) != hipSuccess || per_cu < 1) { fprintf(stderr, "kernel_launch: occupancy query says %d\n", per_cu); }
        (void)hipGetLastError();
        grid = cus;
    }
    if (grid < 0) return;
    (void)hipMemsetAsync((char*)d_ws + WS_CTL, 0, CTL_BYTES, stream);
    Args a{};
    for (int i = 0; i < 25; ++i) a.in[i] = (const float*)d_in[i];
    a.out = (float*)d_out; a.ws = (unsigned char*)d_ws;
#if MK_ONE_LAUNCH
    a.ph_lo = 0; a.ph_hi = NPHASE;
    hipLaunchKernelGGL(mega, dim3(grid), dim3(NTHREADS), LDS_BYTES, stream, a);
#else
    for (int p = 0; p < NPHASE; ++p) { a.ph_lo = p; a.ph_hi = p + 1;
        if ((PROBE_DUP >> p) & 1) { a.dry = 1; hipLaunchKernelGGL(mega, dim3(grid), dim3(NTHREADS), LDS_BYTES, stream, a); }
        a.dry = 0; hipLaunchKernelGGL(mega, dim3(grid), dim3(NTHREADS), LDS_BYTES, stream, a); }
#endif
}
```
